# Optimizing an MI355X kernel written in HIP

```python
import math
import jax, jax.numpy as jnp
from jax import lax
import numpy as np

D_MODEL = 2048
BATCH = 1
SEQ = 8192
DEPTH = 4

N_MIXERS = 2
BLOCK = 128
A_HEADS = 32
A_KV_HEADS = 4
A_HEAD_DIM = 64
A_GROUP = A_HEADS // A_KV_HEADS
WINDOW = 128
A_QKV_DIM = (A_HEADS + 2 * A_KV_HEADS) * A_HEAD_DIM
B_HEADS = 16
B_HEAD_DIM = 64
B_V_DIM = 2 * B_HEAD_DIM
B_QKV_DIM = B_HEADS * (2 * B_HEAD_DIM + 2 * B_HEAD_DIM + B_V_DIM)
P_HEADS = 8
N_KEYS = 128
N_EXPERTS = N_KEYS * N_KEYS
P_TOPK = 16
P_KEY_DIM = 256
P_HALF = P_KEY_DIM // 2
P_CHUNK = 128

LN_EPS = 1e-5
NEG = -1e30
ALPHA = (2.0 * DEPTH) ** 0.25
BETA = (8.0 * DEPTH) ** -0.25
N_A_LAYERS = (DEPTH + 1) // 2
N_B_LAYERS = DEPTH // 2

kernel_name = "hybrid_swa_sink_diffattn_peer_deepnorm"


def alibi_slopes(n):
    return jnp.asarray((2.0 ** (-8.0 * np.arange(1, n + 1) / n)).astype(np.float32))


def layer_norm(x, g, b):
    xf = x.astype(jnp.float32)
    mu = jnp.mean(xf, axis=-1, keepdims=True)
    var = jnp.mean(jnp.square(xf - mu), axis=-1, keepdims=True)
    y = (xf - mu) * lax.rsqrt(var + LN_EPS)
    return (y * g.astype(jnp.float32) + b.astype(jnp.float32)).astype(x.dtype)


def sliding_window_gqa(x, w_qkv, sinks, w_o):
    B, S, _ = x.shape
    nb = S // BLOCK
    d = A_HEAD_DIM
    qkv = x @ w_qkv
    q, k, v = jnp.split(qkv, [A_HEADS * d, (A_HEADS + A_KV_HEADS) * d], axis=-1)
    q = q.reshape(B, nb, BLOCK, A_KV_HEADS, A_GROUP, d)
    k = k.reshape(B, S, A_KV_HEADS, d)
    v = v.reshape(B, S, A_KV_HEADS, d)
    pad = jnp.zeros((B, BLOCK, A_KV_HEADS, d), x.dtype)
    kp = jnp.concatenate([pad, k], axis=1).reshape(B, nb + 1, BLOCK, A_KV_HEADS, d)
    vp = jnp.concatenate([pad, v], axis=1).reshape(B, nb + 1, BLOCK, A_KV_HEADS, d)
    k_band = jnp.concatenate([kp[:, :-1], kp[:, 1:]], axis=2)
    v_band = jnp.concatenate([vp[:, :-1], vp[:, 1:]], axis=2)

    scores = jnp.einsum('bnqhgd,bnkhd->bnhgqk', q, k_band).astype(jnp.float32) * (d ** -0.5)
    qpos = jnp.arange(BLOCK)[:, None] + BLOCK
    kpos = jnp.arange(2 * BLOCK)[None, :]
    dist = qpos - kpos
    blk = jnp.arange(nb)[:, None, None]
    key_abs = (blk - 1) * BLOCK + kpos[None]
    valid = (dist[None] >= 0) & (dist[None] < WINDOW) & (key_abs >= 0)
    slopes = alibi_slopes(A_HEADS).reshape(A_KV_HEADS, A_GROUP)
    scores = scores - slopes[:, :, None, None] * dist.astype(jnp.float32)
    scores = jnp.where(valid[None, :, None, None], scores, NEG)

    sink = sinks.astype(jnp.float32).reshape(A_KV_HEADS, A_GROUP)[:, :, None, None]
    m = jnp.maximum(jnp.max(scores, axis=-1, keepdims=True), sink)
    p = jnp.exp(scores - m)
    denom = jnp.sum(p, axis=-1, keepdims=True) + jnp.exp(sink - m)
    probs = (p / denom).astype(x.dtype)
    o = jnp.einsum('bnhgqk,bnkhd->bnqhgd', probs, v_band)
    return o.reshape(B, S, A_HEADS * d) @ w_o


def differential_attention(x, w_qkv, lq1, lk1, lq2, lk2, subln_g, w_o, lambda_init):
    B, S, _ = x.shape
    nb = S // BLOCK
    d = B_HEAD_DIM
    qkv = x @ w_qkv
    q, k, v = jnp.split(qkv, 3, axis=-1)
    q = q.reshape(B, S, B_HEADS, 2, d)
    k = k.reshape(B, S, B_HEADS, 2, d)
    v = v.reshape(B, S, B_HEADS, B_V_DIM)
    lam = (jnp.exp(jnp.sum(lq1.astype(jnp.float32) * lk1.astype(jnp.float32)))
           - jnp.exp(jnp.sum(lq2.astype(jnp.float32) * lk2.astype(jnp.float32)))
           + lambda_init)
    slopes = alibi_slopes(B_HEADS)[None, :, None, None, None]
    kpos = jnp.arange(S)

    def block(i):
        qb = lax.dynamic_slice_in_dim(q, i * BLOCK, BLOCK, axis=1)
        s = jnp.einsum('bqhcd,bkhcd->bhcqk', qb, k).astype(jnp.float32) * (d ** -0.5)
        qpos = i * BLOCK + jnp.arange(BLOCK)
        dist = qpos[:, None] - kpos[None, :]
        s = s - slopes * dist.astype(jnp.float32)
        s = jnp.where(dist >= 0, s, NEG)
        p = jax.nn.softmax(s, axis=-1)
        pdiff = (p[:, :, 0] - lam * p[:, :, 1]).astype(x.dtype)
        return jnp.einsum('bhqk,bkhe->bqhe', pdiff, v)

    o = lax.map(block, jnp.arange(nb))
    o = o.transpose(1, 0, 2, 3, 4).reshape(B, S, B_HEADS, B_V_DIM)
    of = o.astype(jnp.float32)
    of = of * lax.rsqrt(jnp.mean(jnp.square(of), axis=-1, keepdims=True) + LN_EPS)
    of = of * subln_g.astype(jnp.float32) * (1.0 - lambda_init)
    return of.astype(x.dtype).reshape(B, S, B_HEADS * B_V_DIM) @ w_o


def peer_ffn(x, w_q, subkeys, u, v):
    B, S, D = x.shape
    xt = x.reshape(B * S // P_CHUNK, P_CHUNK, D)

    def chunk(xc):
        T = xc.shape[0]
        q = (xc @ w_q).reshape(T, P_HEADS, 2, P_HALF)
        sc = jnp.einsum('thcd,hckd->thck', q, subkeys).astype(jnp.float32)
        s_top, i_top = lax.top_k(sc, P_TOPK)
        cand = s_top[:, :, 0, :, None] + s_top[:, :, 1, None, :]
        cand_idx = i_top[:, :, 0, :, None] * N_KEYS + i_top[:, :, 1, None, :]
        cand = cand.reshape(T, P_HEADS, P_TOPK * P_TOPK)
        cand_idx = cand_idx.reshape(T, P_HEADS, P_TOPK * P_TOPK)
        best, pos = lax.top_k(cand, P_TOPK)
        experts = jnp.take_along_axis(cand_idx, pos, axis=-1)
        g = jax.nn.softmax(best, axis=-1).reshape(T, P_HEADS * P_TOPK)
        e = experts.reshape(T, P_HEADS * P_TOPK)
        ue = u[e]
        ve = v[e]
        act = jax.nn.gelu(jnp.einsum('ted,td->te', ue, xc).astype(jnp.float32), approximate=False)
        h = (g * act).astype(x.dtype)
        return jnp.einsum('te,ted->td', h, ve)

    return lax.map(chunk, xt).reshape(B, S, D)


def setup_inputs(seed: int = 0) -> dict:
    key = jax.random.key(seed)
    ks = jax.random.split(key, 20)
    f32 = jnp.float32
    D = D_MODEL
    nrm = lambda k, shape, scale: jax.random.normal(k, shape, f32) * scale
    return {
        'x': nrm(ks[0], (BATCH, SEQ, D), 1.0),
        'a_w_qkv': nrm(ks[1], (N_A_LAYERS, D, A_QKV_DIM), D ** -0.5),
        'a_sinks': nrm(ks[2], (N_A_LAYERS, A_HEADS), 0.5),
        'a_w_o': nrm(ks[3], (N_A_LAYERS, A_HEADS * A_HEAD_DIM, D), BETA * (A_HEADS * A_HEAD_DIM) ** -0.5),
        'b_w_qkv': nrm(ks[4], (N_B_LAYERS, D, B_QKV_DIM), D ** -0.5),
        'b_lambda_q1': nrm(ks[5], (N_B_LAYERS, B_HEAD_DIM), 0.1),
        'b_lambda_k1': nrm(ks[6], (N_B_LAYERS, B_HEAD_DIM), 0.1),
        'b_lambda_q2': nrm(ks[7], (N_B_LAYERS, B_HEAD_DIM), 0.1),
        'b_lambda_k2': nrm(ks[8], (N_B_LAYERS, B_HEAD_DIM), 0.1),
        'b_subln_g': 1.0 + nrm(ks[9], (N_B_LAYERS, B_V_DIM), 0.02),
        'b_w_o': nrm(ks[10], (N_B_LAYERS, B_HEADS * B_V_DIM, D), BETA * (B_HEADS * B_V_DIM) ** -0.5),
        'ln1_g': 1.0 + nrm(ks[11], (DEPTH, D), 0.02),
        'ln1_b': nrm(ks[12], (DEPTH, D), 0.02),
        'ln2_g': 1.0 + nrm(ks[13], (DEPTH, D), 0.02),
        'ln2_b': nrm(ks[14], (DEPTH, D), 0.02),
        'peer_w_q': nrm(ks[15], (DEPTH, D, P_HEADS * P_KEY_DIM), D ** -0.5),
        'peer_subkeys': nrm(ks[16], (DEPTH, P_HEADS, 2, N_KEYS, P_HALF), P_HALF ** -0.5),
        'peer_u': nrm(ks[17], (DEPTH, N_EXPERTS, D), D ** -0.5),
        'peer_v': nrm(ks[18], (DEPTH, N_EXPERTS, D), BETA * P_HEADS ** -0.5),
    }


def reference(x, a_w_qkv, a_sinks, a_w_o, b_w_qkv, b_lambda_q1, b_lambda_k1, b_lambda_q2,
              b_lambda_k2, b_subln_g, b_w_o, ln1_g, ln1_b, ln2_g, ln2_b,
              peer_w_q, peer_subkeys, peer_u, peer_v):
    for i in range(DEPTH):
        j = i // N_MIXERS
        if i % N_MIXERS == 0:
            mix = sliding_window_gqa(x, a_w_qkv[j], a_sinks[j], a_w_o[j])
        else:
            lambda_init = 0.8 - 0.6 * math.exp(-0.3 * i)
            mix = differential_attention(x, b_w_qkv[j], b_lambda_q1[j], b_lambda_k1[j],
                                         b_lambda_q2[j], b_lambda_k2[j], b_subln_g[j],
                                         b_w_o[j], lambda_init)
        x = layer_norm(ALPHA * x + mix, ln1_g[i], ln1_b[i])
        ffn = peer_ffn(x, peer_w_q[i], peer_subkeys[i], peer_u[i], peer_v[i])
        x = layer_norm(ALPHA * x + ffn, ln2_g[i], ln2_b[i])
    return x
```

```cpp
#include <hip/hip_runtime.h>
#include <cstdio>
#include <cstdint>
#include <cmath>
namespace pg8 {
#define PG8_LAS __attribute__((address_space(3)))
typedef unsigned short bf16_t;
typedef short bf16x8 __attribute__((ext_vector_type(8)));
typedef float f32x4 __attribute__((ext_vector_type(4)));
typedef unsigned u32x4 __attribute__((ext_vector_type(4)));
constexpr int BM = 256, BK = 64, HALF = 128, HTB = HALF * BK * 2  , STAGE_BYTES = 8 * HTB, NXCD = 8, WGM = 8;

__host__ __device__ __forceinline__ int lds_byte(int r, int c) { const int st = (r >> 4) * 2 + (c >> 5), rr = r & 15, cc = c & 31, ob = rr * 64 + cc * 2; return st * 1024 + (ob ^ (((ob >> 9) & 1) << 5)); }
__host__ __device__ __forceinline__ void stage_rc(int b, int& R, int& C) { const int st = b / 1024, sb = b % 1024, swz = sb ^ (((sb >> 9) & 1) << 5); R = (st >> 1) * 16 + swz / 64; C = (st & 1) * 32 + (swz % 64) / 2; }
__host__ __device__ __forceinline__ int perm32(int rho) { const int n = rho >> 4, i = rho & 15; return 8 * (i >> 2) + 4 * n + (i & 3); }

struct Unit { int pm, pn; };
struct Gemm { const bf16_t* A; const bf16_t* Bt; int M, N, K; int kdiag; };

struct StaticOrder {
    int nM, nN, nwg, G, c;
    __host__ __device__ void init(int M, int N, int G_, int c_) { nM = M / BM; nN = N / BM; nwg = nM * nN; G = G_; c = c_; }
    __host__ __device__ bool next(int i, Unit& u) const {
        const long L = (long)i * G + c; if (L >= nwg) return false;
        int wgid = (int)L; { const int q = nwg / NXCD, r = nwg % NXCD, xcd = wgid % NXCD, off = wgid / NXCD; wgid = (xcd < r ? xcd * (q + 1) : r * (q + 1) + (xcd - r) * q) + off; }
        const int nig = WGM * nN, gid = wgid / nig, fm = gid * WGM, gsz = (nM - fm) < WGM ? (nM - fm) : WGM;
        u.pm = fm + ((wgid % nig) % gsz); u.pn = (wgid % nig) / gsz; return true;
    }
    __device__ __forceinline__ void a_ready(const Unit&) const {}
    __device__ __forceinline__ void done(const Unit&) const {}
};

__device__ __forceinline__ unsigned cvt_pk_bf16(float lo, float hi) { unsigned r; asm volatile("v_cvt_pk_bf16_f32 %0, %1, %2" : "=v"(r) : "v"(lo), "v"(hi)); return r; }
typedef float f32x2 __attribute__((ext_vector_type(2)));
__device__ __forceinline__ f32x2 gelu_pk(f32x2 v) {
    const f32x2 av = __builtin_elementwise_abs(v), d = av * 0.2316418882f + 1.0f;
    f32x2 t; t.x = __builtin_amdgcn_rcpf(d.x); t.y = __builtin_amdgcn_rcpf(d.y);
    f32x2 q = t * 0.5307027145f + (-0.7265760135f); q = q * t + 0.7107068705f; q = q * t + (-0.142248368f); q = q * t + 0.127414796f; q = q * t;
    const f32x2 s = (v * v) * (-0.72134752044f);
    f32x2 e; e.x = __builtin_amdgcn_exp2f(s.x); e.y = __builtin_amdgcn_exp2f(s.y);
    const f32x2 m = v * (q * e), r = v - m;
    f32x2 o; o.x = v.x < 0.f ? m.x : r.x; o.y = v.y < 0.f ? m.y : r.y; return o;
}

template <int ACT  > struct EpiBf16 {
    static constexpr bool PERM = true, AFTER_DRAIN = false; static_assert(ACT == 0 || ACT == 1, "EpiBf16: ACT is 0 (none) or 1 (gelu_pk)");
    bf16_t* O; int ldc; const float* bias; int split_cols; size_t split_stride; float scale0;
    __device__ __forceinline__ void operator()(const f32x4 (&acc)[2][2][4][2], const Unit& u, int wr, int wc, int fr, int fq) const {
        const int row0 = u.pm * BM + wr * 64 + fr; int colt = u.pn * BM; bf16_t* base = O;
        float sc = 1.f; if (split_cols) { const int t = colt / split_cols; base += (size_t)t * split_stride; colt -= t * split_cols; if (t == 0) sc = scale0; }
        const int col0 = colt + wc * 32 + 8 * fq, bcol0 = u.pn * BM + wc * 32 + 8 * fq;
        f32x4 bv[2][2];
#pragma unroll
        for (int bj = 0; bj < 2; ++bj)
#pragma unroll
            for (int n = 0; n < 2; ++n) bv[bj][n] = bias ? *(const f32x4*)(bias + bcol0 + bj * HALF + 4 * n) : (f32x4){0.f, 0.f, 0.f, 0.f};
#pragma unroll
        for (int ai = 0; ai < 2; ++ai)
#pragma unroll
            for (int m = 0; m < 4; ++m) { bf16_t* rowp = base + (size_t)(row0 + ai * HALF + m * 16) * ldc + col0;
#pragma unroll
                for (int bj = 0; bj < 2; ++bj) { f32x4 v0 = acc[ai][bj][m][0] + bv[bj][0], v1 = acc[ai][bj][m][1] + bv[bj][1];
                    if (ACT == 1) { f32x2 a = gelu_pk((f32x2){v0[0], v0[1]}), b = gelu_pk((f32x2){v0[2], v0[3]}), c = gelu_pk((f32x2){v1[0], v1[1]}), d = gelu_pk((f32x2){v1[2], v1[3]});
                        v0 = (f32x4){a.x, a.y, b.x, b.y}; v1 = (f32x4){c.x, c.y, d.x, d.y}; }
                    v0 = v0 * sc; v1 = v1 * sc; u32x4 w; w.x = cvt_pk_bf16(v0[0], v0[1]); w.y = cvt_pk_bf16(v0[2], v0[3]); w.z = cvt_pk_bf16(v1[0], v1[1]); w.w = cvt_pk_bf16(v1[2], v1[3]);
                    *(u32x4*)(rowp + bj * HALF) = w; } }
    }
};
struct EpiBf16S {
    static constexpr bool PERM = true, AFTER_DRAIN = false;
    bf16_t* O; int ldc; int qcols; float scale0; int pn_mask;
    __device__ __forceinline__ void operator()(const f32x4 (&acc)[2][2][4][2], const Unit& u, int wr, int wc, int fr_in, int fq_in) const {
        int l_; asm volatile("v_mbcnt_lo_u32_b32 %0, -1, 0\n\tv_mbcnt_hi_u32_b32 %0, -1, %0" : "=v"(l_)); const int fr = l_ & 15, fq = l_ >> 4; (void)fr_in; (void)fq_in;
        const int row0 = u.pm * BM + wr * 64 + fr; const int colt = (u.pn & pn_mask) * BM;
        const float sc = (colt < qcols) ? scale0 : 1.f;
        const int col0 = colt + wc * 32 + 8 * fq;
#pragma unroll
        for (int ai = 0; ai < 2; ++ai)
#pragma unroll
            for (int m = 0; m < 4; ++m) { bf16_t* rowp = O + (size_t)(row0 + ai * HALF + m * 16) * ldc + col0;
#pragma unroll
                for (int bj = 0; bj < 2; ++bj) { f32x4 v0 = acc[ai][bj][m][0] * sc, v1 = acc[ai][bj][m][1] * sc;
                    u32x4 w; w.x = cvt_pk_bf16(v0[0], v0[1]); w.y = cvt_pk_bf16(v0[2], v0[3]); w.z = cvt_pk_bf16(v1[0], v1[1]); w.w = cvt_pk_bf16(v1[2], v1[3]);
                    *(u32x4*)(rowp + bj * HALF) = w; } }
    }
};
struct EpiResF32 {
    static constexpr bool PERM = true, AFTER_DRAIN = false;
    const float* base; float* out; int ldc; float alpha; float accs;
    __device__ __forceinline__ void operator()(const f32x4 (&acc)[2][2][4][2], const Unit& u, int wr, int wc, int fr_in, int fq_in) const {
        int l_; asm volatile("v_mbcnt_lo_u32_b32 %0, -1, 0\n\tv_mbcnt_hi_u32_b32 %0, -1, %0" : "=v"(l_)); const int fr = l_ & 15, fq = l_ >> 4; (void)fr_in; (void)fq_in;
        const int row0 = u.pm * BM + wr * 64 + fr; const int col0 = u.pn * BM + wc * 32 + 8 * fq;
#pragma unroll
        for (int ai = 0; ai < 2; ++ai)
#pragma unroll
            for (int m = 0; m < 4; ++m) { const size_t off = (size_t)(row0 + ai * HALF + m * 16) * ldc + col0;
#pragma unroll
                for (int bj = 0; bj < 2; ++bj) { const f32x4 b0 = *(const f32x4*)(base + off + bj * HALF), b1 = *(const f32x4*)(base + off + bj * HALF + 4);
                    *(f32x4*)(out + off + bj * HALF) = b0 * alpha + acc[ai][bj][m][0] * accs; *(f32x4*)(out + off + bj * HALF + 4) = b1 * alpha + acc[ai][bj][m][1] * accs; } }
    }
};
struct EpiF32 {
    static constexpr bool PERM = true, AFTER_DRAIN = false;
    float* out; int ldc;
    __device__ __forceinline__ void operator()(const f32x4 (&acc)[2][2][4][2], const Unit& u, int wr, int wc, int fr_in, int fq_in) const {
        int l_; asm volatile("v_mbcnt_lo_u32_b32 %0, -1, 0\n\tv_mbcnt_hi_u32_b32 %0, -1, %0" : "=v"(l_)); const int fr = l_ & 15, fq = l_ >> 4; (void)fr_in; (void)fq_in;
        const int row0 = u.pm * BM + wr * 64 + fr; const int col0 = u.pn * BM + wc * 32 + 8 * fq;
#pragma unroll
        for (int ai = 0; ai < 2; ++ai)
#pragma unroll
            for (int m = 0; m < 4; ++m) { const size_t off = (size_t)(row0 + ai * HALF + m * 16) * ldc + col0;
#pragma unroll
                for (int bj = 0; bj < 2; ++bj) { *(f32x4*)(out + off + bj * HALF) = acc[ai][bj][m][0]; *(f32x4*)(out + off + bj * HALF + 4) = acc[ai][bj][m][1]; } }
    }
};
struct EpiResLnStat {
    static constexpr bool PERM = true, AFTER_DRAIN = false;
    const bf16_t* base; float* out; bf16_t* ob; const float* g; unsigned long long* stat; int ldc; float alpha; float accs;
    __device__ __forceinline__ void operator()(const f32x4 (&acc)[2][2][4][2], const Unit& u, int wr, int wc, int fr_in, int fq_in) const {
        int l_; asm volatile("v_mbcnt_lo_u32_b32 %0, -1, 0\n\tv_mbcnt_hi_u32_b32 %0, -1, %0" : "=v"(l_)); const int fr = l_ & 15, fq = l_ >> 4; (void)fr_in; (void)fq_in;
        const int row0 = u.pm * BM + wr * 64 + fr; const int col0 = u.pn * BM + wc * 32 + 8 * fq;
        f32x4 gv[2][2];
#pragma unroll
        for (int bj = 0; bj < 2; ++bj) { gv[bj][0] = *(const f32x4*)(g + col0 + bj * HALF); gv[bj][1] = *(const f32x4*)(g + col0 + bj * HALF + 4); }
#pragma unroll
        for (int am = 0; am < 4; ++am) { const int ai = am >> 1;
            u32x4 bv[2][2];
#pragma unroll
            for (int mm = 0; mm < 2; ++mm) { const int m = 2 * (am & 1) + mm; const size_t off = (size_t)(row0 + ai * HALF + m * 16) * ldc + col0;
#pragma unroll
                for (int bj = 0; bj < 2; ++bj) bv[mm][bj] = *(const u32x4*)(base + off + bj * HALF); }
#pragma unroll
            for (int mm = 0; mm < 2; ++mm) { const int m = 2 * (am & 1) + mm; const int row = row0 + ai * HALF + m * 16; const size_t off = (size_t)row * ldc + col0; float s1 = 0.f, s2 = 0.f;
#pragma unroll
                for (int bj = 0; bj < 2; ++bj) { const u32x4 bw_ = bv[mm][bj];
                    f32x4 b0, b1; b0[0] = __builtin_bit_cast(float, bw_.x << 16); b0[1] = __builtin_bit_cast(float, bw_.x & 0xffff0000u); b0[2] = __builtin_bit_cast(float, bw_.y << 16); b0[3] = __builtin_bit_cast(float, bw_.y & 0xffff0000u);
                    b1[0] = __builtin_bit_cast(float, bw_.z << 16); b1[1] = __builtin_bit_cast(float, bw_.z & 0xffff0000u); b1[2] = __builtin_bit_cast(float, bw_.w << 16); b1[3] = __builtin_bit_cast(float, bw_.w & 0xffff0000u);
                    const f32x4 y0 = b0 * alpha + acc[ai][bj][m][0] * accs, y1 = b1 * alpha + acc[ai][bj][m][1] * accs;
                    if (out) { *(f32x4*)(out + off + bj * HALF) = y0; *(f32x4*)(out + off + bj * HALF + 4) = y1; }
                    s1 += (y0[0] + y0[1]) + (y0[2] + y0[3]) + (y1[0] + y1[1]) + (y1[2] + y1[3]);
                    s2 += (y0[0] * y0[0] + y0[1] * y0[1]) + (y0[2] * y0[2] + y0[3] * y0[3]) + (y1[0] * y1[0] + y1[1] * y1[1]) + (y1[2] * y1[2] + y1[3] * y1[3]);
                    const f32x4 z0 = y0 * gv[bj][0], z1 = y1 * gv[bj][1];
                    u32x4 w; w.x = cvt_pk_bf16(z0[0], z0[1]); w.y = cvt_pk_bf16(z0[2], z0[3]); w.z = cvt_pk_bf16(z1[0], z1[1]); w.w = cvt_pk_bf16(z1[2], z1[3]);
                    *(u32x4*)(ob + off + bj * HALF) = w; }
                s1 += __shfl_xor(s1, 16); s1 += __shfl_xor(s1, 32); s2 += __shfl_xor(s2, 16); s2 += __shfl_xor(s2, 32);
                if (fq == 0) { atomicAdd(stat + 2 * row, (unsigned long long)(long long)(s1 * 4294967296.f)); atomicAdd(stat + 2 * row + 1, (unsigned long long)(long long)(s2 * 4294967296.f)); } }
        }
    }
};
struct EpiScLn {
    static constexpr bool PERM = true, AFTER_DRAIN = false;
    _Float16* out; int ldc; const long long* stat; const float* cs; const float* bw; float inv_n; float eps;
    __device__ __forceinline__ void operator()(const f32x4 (&acc)[2][2][4][2], const Unit& u, int wr, int wc, int fr_in, int fq_in) const {
        int l_; asm volatile("v_mbcnt_lo_u32_b32 %0, -1, 0\n\tv_mbcnt_hi_u32_b32 %0, -1, %0" : "=v"(l_)); const int fr = l_ & 15, fq = l_ >> 4; (void)fr_in; (void)fq_in;
        const int row0 = u.pm * BM + wr * 64 + fr; const int col0 = u.pn * BM + wc * 32 + 8 * fq;
        f32x4 cv[2][2], bv[2][2];
#pragma unroll
        for (int bj = 0; bj < 2; ++bj) { cv[bj][0] = *(const f32x4*)(cs + col0 + bj * HALF); cv[bj][1] = *(const f32x4*)(cs + col0 + bj * HALF + 4); bv[bj][0] = *(const f32x4*)(bw + col0 + bj * HALF); bv[bj][1] = *(const f32x4*)(bw + col0 + bj * HALF + 4); }
        long long st[2][4][2];
#pragma unroll
        for (int ai = 0; ai < 2; ++ai)
#pragma unroll
            for (int m = 0; m < 4; ++m) { const int row = row0 + ai * HALF + m * 16; st[ai][m][0] = stat[2 * row]; st[ai][m][1] = stat[2 * row + 1]; }
#pragma unroll
        for (int ai = 0; ai < 2; ++ai)
#pragma unroll
            for (int m = 0; m < 4; ++m) { const int row = row0 + ai * HALF + m * 16; const size_t off = (size_t)row * ldc + col0;
                const float s1 = (float)st[ai][m][0] * 2.3283064365386963e-10f, s2 = (float)st[ai][m][1] * 2.3283064365386963e-10f; const float mu = s1 * inv_n, var = s2 * inv_n - mu * mu; const float rstd = 1.f / __builtin_sqrtf(var + eps), mr = mu * rstd;
#pragma unroll
                for (int bj = 0; bj < 2; ++bj) { const f32x4 v0 = acc[ai][bj][m][0] * rstd - cv[bj][0] * mr + bv[bj][0], v1 = acc[ai][bj][m][1] * rstd - cv[bj][1] * mr + bv[bj][1];
                    typedef _Float16 h8 __attribute__((ext_vector_type(8))); typedef float f8 __attribute__((ext_vector_type(8)));
                    const f8 vv = {v0[0], v0[1], v0[2], v0[3], v1[0], v1[1], v1[2], v1[3]};
                    *(h8*)(out + off + bj * HALF) = __builtin_convertvector(vv, h8); } }
    }
};
struct StackOrder {
    StaticOrder S;
    __host__ __device__ void init(int M, int N, int G_, int c_) { S.init(M, N, G_, c_); }
    __host__ __device__ bool next(int i, Unit& u) const { if (!S.next(i, u)) return false; u.pn += (u.pm >> 3) * 8; return true; }
    __device__ __forceinline__ void a_ready(const Unit&) const {}
    __device__ __forceinline__ void done(const Unit&) const {}
};
template <class Epi, class Sched, bool ALIGN_EPI = false, bool SP2 = false>
__device__ __forceinline__ void gemm_phase(PG8_LAS unsigned char* lds, const Gemm g, const Sched& S, const Epi& E, const int wave_id) {
    int lane_; asm volatile("v_mbcnt_lo_u32_b32 %0, -1, 0\n\tv_mbcnt_hi_u32_b32 %0, -1, %0" : "=v"(lane_));
    const int wid = wave_id, lane = lane_, tid = wid * 64 + lane, wr = wid >> 2, wc = wid & 3, fr = lane & 15, fq = lane >> 4;
    const int K = g.K, nt = g.kdiag ? 4 : K / BK;
    unsigned voffA[2], voffB[2];
#pragma unroll
    for (int i = 0; i < 2; ++i) { int R, C; stage_rc(tid * 16 + i * 8192, R, C); const int Rb = Epi::PERM ? ((R & ~31) + perm32(R & 31)) : R;
        voffA[i] = (unsigned)(R * K + C) * 2u; voffB[i] = (unsigned)(Rb * K + C) * 2u; }
    const size_t kstep = (size_t)(BK * 2);
    const size_t hstep = (size_t)HALF * K * 2;
    const size_t tstep = 2 * hstep;
    const unsigned ldsw = (unsigned)wid * 1024u;
    const int aoff = lds_byte(wr * 64 + fr, fq * 8), boff = lds_byte(wc * 32 + fr, fq * 8);
#define PG8_SA(b, h) (((b) * 2 + (h)) * HTB)
#define PG8_SB(b, h) ((4 + (b) * 2 + (h)) * HTB)
#define PG8_STAGE(bufoff, gbase, voff) do { _Pragma("unroll") for (int _i = 0; _i < 2; ++_i) \
        __builtin_amdgcn_global_load_lds((const unsigned*)((const char*)(gbase) + (voff)[_i]), (PG8_LAS unsigned*)(lds + (bufoff) + ldsw + _i * 8192), 16, 0, 0); } while (0)
#define PG8_LDA(dst, b, h) do { _Pragma("unroll") for (int m = 0; m < 4; ++m) _Pragma("unroll") for (int k = 0; k < 2; ++k) dst[m][k] = *(const PG8_LAS bf16x8*)(lds + PG8_SA(b, h) + aoff + m * 2048 + k * 1024); } while (0)
#define PG8_LDB(dst, b, h) do { _Pragma("unroll") for (int n = 0; n < 2; ++n) _Pragma("unroll") for (int k = 0; k < 2; ++k) dst[n][k] = *(const PG8_LAS bf16x8*)(lds + PG8_SB(b, h) + boff + n * 2048 + k * 1024); } while (0)
#define PG8_MMA(ai, bj, At, Bt) do { __builtin_amdgcn_s_setprio(1); _Pragma("unroll") for (int m = 0; m < 4; ++m) _Pragma("unroll") for (int n = 0; n < 2; ++n) _Pragma("unroll") for (int k = 0; k < 2; ++k) \
        acc[ai][bj][m][n] = __builtin_amdgcn_mfma_f32_16x16x32_bf16(Bt[n][k], At[m][k], acc[ai][bj][m][n], 0, 0, 0); __builtin_amdgcn_s_setprio(0); } while (0)
#define PG8_WAIT_V(n) asm volatile("s_waitcnt vmcnt(" #n ")" ::: "memory")
#define PG8_WAIT_L(n) asm volatile("s_waitcnt lgkmcnt(" #n ")" ::: "memory")
#define PG8_BAR __builtin_amdgcn_s_barrier()
#define PG8_SCHED __builtin_amdgcn_sched_barrier(0)
    Unit cur, nxt; int ui = 0;
    if (!S.next(0, cur)) return;
    f32x4 acc[2][2][4][2];
#pragma unroll
    for (int a = 0; a < 2; ++a)
#pragma unroll
        for (int b = 0; b < 2; ++b)
#pragma unroll
            for (int m = 0; m < 4; ++m)
#pragma unroll
                for (int n = 0; n < 2; ++n) acc[a][b][m][n] = (f32x4){0.f, 0.f, 0.f, 0.f};
    bf16x8 At[4][2], B0[2][2], B1[2][2];
    const char* cA = (const char*)g.A + (size_t)cur.pm * tstep + (g.kdiag ? (size_t)(cur.pm & 7) * 512 : (size_t)0); const char* cB = (const char*)g.Bt + (size_t)cur.pn * tstep + (g.kdiag ? (size_t)(cur.pm & 7) * 512 : (size_t)0);
    S.a_ready(cur);
    if constexpr (SP2) {
        PG8_STAGE(PG8_SB(0, 0), cB, voffB); PG8_STAGE(PG8_SB(0, 1), cB + hstep, voffB); PG8_STAGE(PG8_SA(0, 0), cA, voffA); PG8_STAGE(PG8_SA(0, 1), cA + hstep, voffA);
        if (wr == 1) PG8_BAR;
        PG8_WAIT_V(2); PG8_BAR;
        PG8_STAGE(PG8_SB(1, 0), cB + kstep, voffB); PG8_STAGE(PG8_SA(1, 0), cA + kstep, voffA); PG8_STAGE(PG8_SB(1, 1), cB + hstep + kstep, voffB);
        PG8_WAIT_V(6); PG8_BAR;
    } else {
        PG8_STAGE(PG8_SB(0, 0), cB, voffB); PG8_STAGE(PG8_SA(0, 0), cA, voffA); PG8_STAGE(PG8_SB(0, 1), cB + hstep, voffB); PG8_STAGE(PG8_SA(0, 1), cA + hstep, voffA);
        if (wr == 1) PG8_BAR;
        PG8_WAIT_V(4); PG8_BAR;
        PG8_STAGE(PG8_SB(1, 0), cB + kstep, voffB); PG8_STAGE(PG8_SA(1, 0), cA + kstep, voffA); PG8_STAGE(PG8_SB(1, 1), cB + hstep + kstep, voffB);
        PG8_WAIT_V(6); PG8_BAR;
    }
    for (;;) {
        const bool has_next = S.next(ui + 1, nxt);
        const size_t nkd = (g.kdiag && has_next) ? (size_t)(nxt.pm & 7) * 512 : (size_t)0; const char* nA = has_next ? (const char*)g.A + (size_t)nxt.pm * tstep + nkd : cA; const char* nB = has_next ? (const char*)g.Bt + (size_t)nxt.pn * tstep + nkd : cB;
        for (int t = 0; t < nt; t += 2) {
            const bool last = (t == nt - 2);
            const char* a1 = cA + (size_t)(t + 1) * kstep;
            const char* a2 = last ? nA : cA + (size_t)(t + 2) * kstep; const char* b2 = last ? nB : cB + (size_t)(t + 2) * kstep;
            const char* a3 = a2 + kstep; const char* b3 = b2 + kstep;
            if (last && has_next) S.a_ready(nxt);
            if constexpr (SP2) {
            PG8_LDB(B0, 0, 0); PG8_LDB(B1, 0, 1); PG8_SCHED; PG8_LDA(At, 0, 0); PG8_STAGE(PG8_SA(1, 1), a1 + hstep, voffA);
            PG8_WAIT_V(8); PG8_WAIT_L(0); PG8_BAR; PG8_MMA(0, 0, At, B0); PG8_MMA(0, 1, At, B1); PG8_BAR; PG8_SCHED;
            PG8_LDA(At, 0, 1); PG8_STAGE(PG8_SB(0, 0), b2, voffB); PG8_STAGE(PG8_SB(0, 1), b2 + hstep, voffB); PG8_STAGE(PG8_SA(0, 0), a2, voffA);
            PG8_WAIT_V(8); PG8_WAIT_L(0); PG8_BAR; PG8_MMA(1, 0, At, B0); PG8_MMA(1, 1, At, B1); PG8_BAR; PG8_SCHED;
            PG8_LDB(B0, 1, 0); PG8_LDB(B1, 1, 1); PG8_SCHED; PG8_LDA(At, 1, 0); PG8_STAGE(PG8_SA(0, 1), a2 + hstep, voffA);
            PG8_WAIT_V(8); PG8_WAIT_L(0); PG8_BAR; PG8_MMA(0, 0, At, B0); PG8_MMA(0, 1, At, B1); PG8_BAR; PG8_SCHED;
            PG8_LDA(At, 1, 1); PG8_STAGE(PG8_SB(1, 0), b3, voffB); PG8_STAGE(PG8_SB(1, 1), b3 + hstep, voffB); PG8_STAGE(PG8_SA(1, 0), a3, voffA);
            PG8_WAIT_V(8); PG8_WAIT_L(0); PG8_BAR; PG8_MMA(1, 0, At, B0); PG8_MMA(1, 1, At, B1); PG8_BAR; PG8_SCHED;
            } else {
            PG8_LDB(B0, 0, 0); PG8_SCHED; PG8_LDA(At, 0, 0); PG8_STAGE(PG8_SA(1, 1), a1 + hstep, voffA);
            PG8_WAIT_L(8); PG8_BAR; PG8_WAIT_L(0); PG8_MMA(0, 0, At, B0); PG8_BAR; PG8_SCHED;
            PG8_LDB(B1, 0, 1); PG8_STAGE(PG8_SB(0, 0), b2, voffB);
            PG8_BAR; PG8_WAIT_L(0); PG8_MMA(0, 1, At, B1); PG8_BAR;
            PG8_LDA(At, 0, 1); PG8_STAGE(PG8_SA(0, 0), a2, voffA);
            PG8_BAR; PG8_WAIT_L(0); PG8_MMA(1, 0, At, B0); PG8_BAR; PG8_SCHED;
            PG8_STAGE(PG8_SB(0, 1), b2 + hstep, voffB);
            PG8_WAIT_V(6); PG8_BAR; PG8_MMA(1, 1, At, B1); PG8_BAR;
            PG8_LDB(B0, 1, 0); PG8_SCHED; PG8_LDA(At, 1, 0); PG8_STAGE(PG8_SA(0, 1), a2 + hstep, voffA);
            PG8_WAIT_L(8); PG8_BAR; PG8_WAIT_L(0); PG8_MMA(0, 0, At, B0); PG8_BAR; PG8_SCHED;
            PG8_LDB(B1, 1, 1); PG8_STAGE(PG8_SB(1, 0), b3, voffB);
            PG8_BAR; PG8_WAIT_L(0); PG8_MMA(0, 1, At, B1); PG8_BAR;
            PG8_LDA(At, 1, 1); PG8_STAGE(PG8_SA(1, 0), a3, voffA);
            PG8_BAR; PG8_WAIT_L(0); PG8_MMA(1, 0, At, B0); PG8_BAR; PG8_SCHED;
            PG8_STAGE(PG8_SB(1, 1), b3 + hstep, voffB);
            PG8_WAIT_V(6); PG8_BAR; PG8_MMA(1, 1, At, B1); PG8_BAR;
            }
        }
        if constexpr (ALIGN_EPI) { if (wr == 0) PG8_BAR; }
        if constexpr (!Epi::AFTER_DRAIN) { E(acc, cur, wr, wc, fr, fq); S.done(cur); }
        if (!has_next) break;
#pragma unroll
        for (int a = 0; a < 2; ++a)
#pragma unroll
            for (int b = 0; b < 2; ++b)
#pragma unroll
                for (int m = 0; m < 4; ++m)
#pragma unroll
                    for (int n = 0; n < 2; ++n) acc[a][b][m][n] = (f32x4){0.f, 0.f, 0.f, 0.f};
        cur = nxt; cA = nA; cB = nB; ++ui;
        if constexpr (ALIGN_EPI) { if (wr == 1) PG8_BAR; }
    }
    PG8_WAIT_V(0);
    if constexpr (!ALIGN_EPI) { if (wr == 0) PG8_BAR; }
    PG8_BAR;
    if constexpr (Epi::AFTER_DRAIN) { E.fused(acc, cur, wr, wc, fr, fq, lds, wid, lane); S.done(cur); }
#undef PG8_SA
#undef PG8_SB
#undef PG8_STAGE
#undef PG8_LDA
#undef PG8_LDB
#undef PG8_MMA
#undef PG8_WAIT_V
#undef PG8_WAIT_L
#undef PG8_BAR
#undef PG8_SCHED
}
}

#ifndef STOP_AFTER
#define STOP_AFTER -1
#endif
#ifndef COPY_SRC
#define COPY_SRC 0
#endif
#ifndef U_FP4
#define U_FP4 1
#endif
#ifndef V_FP4
#define V_FP4 1
#endif
#ifndef PEER_DRY
#define PEER_DRY 3
#endif
#ifndef DA_CMAX
#define DA_CMAX 48
#endif
#ifndef P0_RPT
#define P0_RPT 0
#endif
#ifndef TABLE_FILL
#define TABLE_FILL 1
#endif
#ifndef FILL_TAB
#define FILL_TAB 0
#endif
#ifndef PEER_BANDS
#define PEER_BANDS 16
#endif
#ifndef U_I4
#define U_I4 1
#endif
#ifndef U_CHUNKED
#define U_CHUNKED 1
#endif
#ifndef RPT_MASK
#define RPT_MASK 0
#endif
#ifndef PROBE_MASK
#define PROBE_MASK 0
#endif
#ifndef DIAG_LAYER
#define DIAG_LAYER 0
#endif
#ifndef DIAG_A
#define DIAG_A 0
#endif
#ifndef DIAG_B
#define DIAG_B 2
#endif
#ifndef PEER_HS
#define PEER_HS 0x4444
#endif
constexpr int NWAVES = 8;
constexpr int T = 8192, D = 2048, DEPTH = 4;
constexpr int A_QKV = 2560, B_QKV = 6144;
constexpr int NE = 16384;
constexpr float LN_EPS = 1e-5f;
constexpr float ALPHA = 1.6817928305074290f;
constexpr float LOG2E = 1.4426950408889634f;
constexpr float C2 = 0.125f * LOG2E;
constexpr float NEGBIG = -1e30f;
constexpr int N_PHASES = 2 + 6 * DEPTH;

constexpr size_t MiB = 1u << 20;
constexpr size_t WS_CTL = 0, CTL_ZERO_BYTES = 2 * MiB;
constexpr size_t WS_WQKVA = 2 * MiB;
constexpr size_t WS_WQKVB = WS_WQKVA + 20 * MiB;
constexpr size_t WS_WO    = WS_WQKVB + 48 * MiB;
constexpr size_t WS_WEFF  = WS_WO + 32 * MiB;
constexpr size_t WS_ABLK  = WS_WEFF + 32 * MiB;
constexpr size_t WS_WQB   = WS_ABLK + 32 * MiB;
constexpr size_t WS_XB    = WS_WQB + 32 * MiB;
constexpr size_t WS_XF    = WS_XB + 32 * MiB;
constexpr size_t WS_YF    = WS_XF + 64 * MiB;
constexpr size_t WS_QKV   = WS_YF + 64 * MiB;
constexpr size_t WS_OB    = WS_QKV + 96 * MiB;
constexpr size_t WS_SC    = WS_OB + 32 * MiB;
constexpr size_t WS_STASH = WS_SC + 64 * MiB;
constexpr size_t WS_UT    = WS_STASH + 32 * MiB;
constexpr size_t WS_VT    = WS_UT + 128 * MiB;
constexpr size_t WS_US    = WS_VT + 128 * MiB;
constexpr size_t WS_VS    = WS_US + 1 * MiB;
constexpr size_t WS_CSW   = WS_VS + 1 * MiB;
constexpr size_t WS_END   = WS_CSW + 1 * MiB;
constexpr int CW_TMO = 0, CW_CODE = 1;
constexpr int CW_DA = 2048;
constexpr int CW_CVT = 1024;
constexpr size_t WS_STAT = 1 * MiB;
constexpr int CW_BAR = 4096;

constexpr int RING_OFF = 0, RING_BYTES = 131072;
constexpr int LDSCTL_OFF = RING_BYTES, MISC_OFF = LDSCTL_OFF + 320;
constexpr int LDS_BYTES = 147456;

#define GAS __attribute__((address_space(1)))
#define LAS __attribute__((address_space(3)))
typedef unsigned short bf16;
typedef unsigned v4u __attribute__((ext_vector_type(4)));
typedef unsigned v2u __attribute__((ext_vector_type(2)));
typedef unsigned v3u __attribute__((ext_vector_type(3)));
typedef unsigned v6u __attribute__((ext_vector_type(6)));
typedef float f32x32 __attribute__((ext_vector_type(32)));
typedef float f32x4 __attribute__((ext_vector_type(4)));
typedef float f32x16 __attribute__((ext_vector_type(16)));
typedef short bf16x8 __attribute__((ext_vector_type(8)));
typedef short s16x4 __attribute__((ext_vector_type(4)));
typedef __bf16 bf16x2_t __attribute__((ext_vector_type(2)));
typedef GAS unsigned gu32;
#define RLX_AGENT __ATOMIC_RELAXED, __HIP_MEMORY_SCOPE_AGENT
#define LDS_WAIT() asm volatile("s_waitcnt lgkmcnt(0)" ::: "memory")
#define VM_WAIT() asm volatile("s_waitcnt vmcnt(0)" ::: "memory")
typedef float f32x2_t __attribute__((ext_vector_type(2)));
__device__ __forceinline__ unsigned pkbf(float lo, float hi) { const f32x2_t v = {lo, hi}; const bf16x2_t b = __builtin_convertvector(v, bf16x2_t); return __builtin_bit_cast(unsigned, b); }
#define MFMA32(a, b, c) __builtin_amdgcn_mfma_f32_32x32x16_bf16(a, b, c, 0, 0, 0)
__device__ __forceinline__ int lane_id() { int l; asm volatile("v_mbcnt_lo_u32_b32 %0, -1, 0\n\tv_mbcnt_hi_u32_b32 %0, -1, %0" : "=v"(l)); return l; }
__device__ __forceinline__ int opaque_u(int x) { int v; asm volatile("v_mov_b32 %0, %1" : "=v"(v) : "s"(x)); return __builtin_amdgcn_readfirstlane(v); }
#define XB_TMO      128
#define XB_XCNT(j)  (256  + 64 * (j))
#define XB_XSUB(j)  (1280 + 64 * (j))
#define XB_XGEN(j)  (2304 + 64 * (j))
#define XB_TOP      3328
#define XB_TOPGEN   3392
#define XCD_BAR_WORDS 3456
#define XB_SPIN_CAP (1u << 21)

__device__ __forceinline__ unsigned xb_ld(unsigned* p)              { return __hip_atomic_load(p, __ATOMIC_RELAXED, __HIP_MEMORY_SCOPE_AGENT); }
__device__ __forceinline__ unsigned xb_add(unsigned* p, unsigned v) { return __hip_atomic_fetch_add(p, v, __ATOMIC_RELAXED, __HIP_MEMORY_SCOPE_AGENT); }
__device__ __forceinline__ unsigned xb_xcc_id() { return (unsigned)__builtin_amdgcn_s_getreg((3 << 11) | 20) & 0xFu; }
#define XB_SPIN(cond, bar) do { unsigned _sp = 0; while (cond) { __builtin_amdgcn_s_sleep(1); \
    if ((++_sp & 255u) == 0u) { if (xb_ld(&(bar)[XB_TMO])) break; if (_sp > XB_SPIN_CAP) { atomicAdd(&(bar)[XB_TMO], 1u); break; } } } } while (0)

struct XcdBarrier {
    unsigned* bar; unsigned x; int wave;
    volatile LAS unsigned* st;
};

__device__ __forceinline__ XcdBarrier xcd_barrier_post(unsigned* bar, volatile LAS unsigned* st) {
    XcdBarrier b; b.bar = bar; b.x = xb_xcc_id(); b.st = st; b.wave = __builtin_amdgcn_readfirstlane((int)(threadIdx.x >> 6));
    if (threadIdx.x == 0) (void)xb_add(&bar[XB_XCNT(b.x)], 1u);
    return b;
}
__device__ __forceinline__ void xcd_barrier_complete(unsigned* bar, unsigned x, unsigned& nloc, unsigned& nx) {
    const unsigned G = gridDim.x * gridDim.y * gridDim.z;
    unsigned sum, cnt, mine, sp = 0u;
    for (;;) {
        sum = 0u; cnt = 0u; mine = 0u;
#pragma unroll
        for (unsigned j = 0; j < 16; ++j) { const unsigned c = xb_ld(&bar[XB_XCNT(j)]); sum += c; cnt += (c > 0u) ? 1u : 0u; mine = (j == x) ? c : mine; }
        if (sum == G) break;
        __builtin_amdgcn_s_sleep(1);
        if ((++sp & 255u) == 0u) { if (xb_ld(&bar[XB_TMO])) break; if (sp > XB_SPIN_CAP) { atomicAdd(&bar[XB_TMO], 1u); break; } }
    }
    nloc = mine > 0u ? mine : 1u; nx = cnt > 0u ? cnt : 1u;
}

__device__ __forceinline__ void xcd_barrier(const XcdBarrier& b) {
    asm volatile("s_waitcnt vmcnt(0)" ::: "memory");
    __syncthreads();
    if (b.wave == 0 && lane_id() == 0) {
        unsigned* bar = b.bar;
        __builtin_amdgcn_s_waitcnt(0);
        unsigned nloc = b.st[0], nx = b.st[1];
        if (nloc == 0u) { xcd_barrier_complete(bar, b.x, nloc, nx); b.st[0] = nloc; b.st[1] = nx; }
        const unsigned old = xb_add(&bar[XB_XSUB(b.x)], 1u);
        const unsigned gen = old / nloc;
        if (old + 1u == (gen + 1u) * nloc) {
            __builtin_amdgcn_fence(__ATOMIC_RELEASE, "agent");
            asm volatile("s_waitcnt vmcnt(0)" ::: "memory");
            const unsigned og = xb_add(&bar[XB_TOP], 1u);
            const unsigned tg = og / nx;
            if (og + 1u == (tg + 1u) * nx) xb_add(&bar[XB_TOPGEN], 1u);
            else XB_SPIN(xb_ld(&bar[XB_TOPGEN]) == tg, bar);
            __builtin_amdgcn_fence(__ATOMIC_ACQUIRE, "agent");
            xb_add(&bar[XB_XGEN(b.x)], 1u);
            asm volatile("s_waitcnt vmcnt(0)" ::: "memory");
        } else {
            XB_SPIN(xb_ld(&bar[XB_XGEN(b.x)]) == gen, bar);
            __builtin_amdgcn_fence(__ATOMIC_ACQUIRE, "agent");
            asm volatile("s_waitcnt vmcnt(0)" ::: "memory");
        }
    }
    __syncthreads();
}

struct Frame {
    LAS unsigned char* lds;
    int wave;
    int vcu, G;
};
constexpr int PT_OFF = LDSCTL_OFF + 1024, PT_OUT = 19, PT_WS = 20;
__device__ __forceinline__ unsigned long long ldp_raw(const Frame& F, int k) {
    const unsigned long long v = *(volatile LAS unsigned long long*)(F.lds + PT_OFF + 8 * k);
    const unsigned lo = __builtin_amdgcn_readfirstlane((unsigned)v), hi = __builtin_amdgcn_readfirstlane((unsigned)(v >> 32));
    return ((unsigned long long)hi << 32) | lo;
}
__device__ __forceinline__ const float* ldin(const Frame& F, int k) { return (const float*)ldp_raw(F, k); }
__device__ __forceinline__ unsigned char* ldws(const Frame& F) { return (unsigned char*)ldp_raw(F, PT_WS); }
#define DPPF(x, ctrl) __builtin_bit_cast(float, __builtin_amdgcn_update_dpp(0, __builtin_bit_cast(int, (float)(x)), (ctrl), 0xF, 0xF, false))
__device__ __forceinline__ float xor1f(float x) { return DPPF(x, 0xB1); }
__device__ __forceinline__ float xor2f(float x) { return DPPF(x, 0x4E); }
__device__ __forceinline__ float xor4f(float x) { const float t = DPPF(x, 0x141); return DPPF(t, 0x1B); }
__device__ __forceinline__ float xor8f(float x) { return DPPF(x, 0x128); }
__device__ __forceinline__ float swapsum16(float a, float b) { asm volatile("s_nop 1\n\tv_permlane16_swap_b32 %0, %1\n\ts_nop 1" : "+v"(a), "+v"(b)); return a + b; }
__device__ __forceinline__ float swapsum32(float a, float b) { asm volatile("s_nop 1\n\tv_permlane32_swap_b32 %0, %1\n\ts_nop 1" : "+v"(a), "+v"(b)); return a + b; }
__device__ __forceinline__ float wave_sum(float v) {
    v += xor1f(v); v += xor2f(v); v += xor4f(v); v += xor8f(v); v = swapsum16(v, v); v = swapsum32(v, v);
    return v;
}
__device__ __forceinline__ float wave_max_all(float v) {
    v = fmaxf(v, xor1f(v)); v = fmaxf(v, xor2f(v)); v = fmaxf(v, xor4f(v)); v = fmaxf(v, xor8f(v));
    { float a = v, c = v; asm volatile("s_nop 1\n\tv_permlane16_swap_b32 %0, %1\n\ts_nop 1" : "+v"(a), "+v"(c)); v = fmaxf(a, c); }
    { float a = v, c = v; asm volatile("s_nop 1\n\tv_permlane32_swap_b32 %0, %1\n\ts_nop 1" : "+v"(a), "+v"(c)); v = fmaxf(a, c); }
    return v;
}
__device__ __forceinline__ float bf_lo(unsigned w) { return __builtin_bit_cast(float, w << 16); }
__device__ __forceinline__ float bf_hi(unsigned w) { return __builtin_bit_cast(float, w & 0xffff0000u); }

__device__ __forceinline__ void p0_transpose_item(const float* W, int K, int N, bf16* WT, LAS float* scr, int item, int lane) {
    const int nblk = N / 32, kb = item / nblk, nb = item % nblk, k0 = 64 * kb, n0 = 32 * nb;
    float tv[32];
#pragma unroll
    for (int i = 0; i < 32; ++i) tv[i] = W[(size_t)(k0 + 2 * i + (lane >> 5)) * N + n0 + (lane & 31)];
#pragma unroll
    for (int i = 0; i < 32; ++i) scr[(2 * i + (lane >> 5)) * 33 + (lane & 31)] = tv[i];
    LDS_WAIT(); asm volatile("" ::: "memory");
    const int c = lane & 7;
#pragma unroll
    for (int j = 0; j < 4; ++j) { const int n = (lane >> 3) + 8 * j; const LAS float* s = scr + (8 * c) * 33 + n;
        v4u o; o.x = pkbf(s[0 * 33], s[1 * 33]); o.y = pkbf(s[2 * 33], s[3 * 33]); o.z = pkbf(s[4 * 33], s[5 * 33]); o.w = pkbf(s[6 * 33], s[7 * 33]);
        *(GAS v4u*)(WT + (size_t)(n0 + n) * K + k0 + 8 * c) = o; }
    LDS_WAIT(); asm volatile("" ::: "memory");
}
__device__ __forceinline__ void cvt_stream(const float* src, bf16* dst, size_t n8, size_t gt, size_t GT) {
    const GAS f32x4* s = (const GAS f32x4*)src; GAS v4u* d = (GAS v4u*)dst;
    size_t i = gt;
    for (; i + GT < n8; i += 2 * GT) {
        const f32x4 a0 = s[2 * i], b0 = s[2 * i + 1], a1 = s[2 * (i + GT)], b1 = s[2 * (i + GT) + 1];
        v4u o0, o1; o0.x = pkbf(a0.x, a0.y); o0.y = pkbf(a0.z, a0.w); o0.z = pkbf(b0.x, b0.y); o0.w = pkbf(b0.z, b0.w);
        o1.x = pkbf(a1.x, a1.y); o1.y = pkbf(a1.z, a1.w); o1.z = pkbf(b1.x, b1.y); o1.w = pkbf(b1.z, b1.w);
        d[i] = o0; d[i + GT] = o1; }
    for (; i < n8; i += GT) { const f32x4 a0 = s[2 * i], b0 = s[2 * i + 1]; v4u o0; o0.x = pkbf(a0.x, a0.y); o0.y = pkbf(a0.z, a0.w); o0.z = pkbf(b0.x, b0.y); o0.w = pkbf(b0.z, b0.w); d[i] = o0; }
}
__device__ __forceinline__ unsigned enc_e2m3(float x) {
    const unsigned ub = __builtin_bit_cast(unsigned, x), ua = ub & 0x7fffffffu; const float a = __builtin_bit_cast(float, ua);
    unsigned r;
    if (a >= 1.0f) { const unsigned u = ua + 0x7FFFFu + ((ua >> 20) & 1u); r = (u >> 20) - (127u << 3) + 8u; }
    else r = (unsigned)__builtin_rintf(a * 8.f);
    r = r > 31u ? 31u : r;
    return r | ((ub >> 26) & 32u);
}
__device__ __forceinline__ unsigned dpp_quad(unsigned v, int sel) {
    return sel == 0 ? (unsigned)__builtin_amdgcn_mov_dpp((int)v, 0x00, 0xF, 0xF, true) : sel == 1 ? (unsigned)__builtin_amdgcn_mov_dpp((int)v, 0x55, 0xF, 0xF, true)
         : sel == 2 ? (unsigned)__builtin_amdgcn_mov_dpp((int)v, 0xAA, 0xF, 0xF, true) : (unsigned)__builtin_amdgcn_mov_dpp((int)v, 0xFF, 0xF, 0xF, true); }
__device__ __forceinline__ void row_scale(float am, float target, float& sc, float& isc) {
    sc = 1.f; isc = 1.f;
    if (am > 1e-30f) { const float q = target / am; int ex = (int)((__builtin_bit_cast(unsigned, q) >> 23) & 255u) - 127; ex = ex > 60 ? 60 : (ex < -60 ? -60 : ex);
        sc = __builtin_bit_cast(float, (unsigned)(ex + 127) << 23); isc = __builtin_bit_cast(float, (unsigned)(127 - ex) << 23); }
}
#ifndef FP6_HW
#define FP6_HW 1
#endif
__device__ __forceinline__ void cvt_rows_fp6(const float* src, unsigned char* dst, float* inv, int nrows, int gw, int NGW, int lane) {
    f32x4 nx[8];
    if (gw < nrows) { const GAS f32x4* s = (const GAS f32x4*)(src + (size_t)gw * D) + lane * 8;
#pragma unroll
        for (int q = 0; q < 8; ++q) nx[q] = s[q]; }
    for (int r = gw; r < nrows; r += NGW) {
        f32x4 v[8]; float am = 0.f;
#pragma unroll
        for (int q = 0; q < 8; ++q) v[q] = nx[q];
        { const int rn = r + NGW; if (rn < nrows) { const GAS f32x4* s = (const GAS f32x4*)(src + (size_t)rn * D) + lane * 8;
#pragma unroll
            for (int q = 0; q < 8; ++q) nx[q] = s[q]; } }
#pragma unroll
        for (int q = 0; q < 8; ++q) am = fmaxf(am, fmaxf(fmaxf(fabsf(v[q].x), fabsf(v[q].y)), fmaxf(fabsf(v[q].z), fabsf(v[q].w))));
#pragma unroll
        for (int o = 1; o < 64; o <<= 1) am = fmaxf(am, __shfl_xor(am, o));
        float sc, isc; row_scale(am, 7.5f, sc, isc);
        v6u w; bool ok = false;
#if FP6_HW
        {
            f32x16 ev, od;
#pragma unroll
            for (int i = 0; i < 16; ++i) { ev[i] = v[i >> 1][(2 * i) & 3]; od[i] = v[i >> 1][(2 * i + 1) & 3]; }
            w = __builtin_amdgcn_cvt_scalef32_2xpk16_fp6_f32(ev, od, isc);
            const f32x32 back = __builtin_amdgcn_cvt_scalef32_pk32_f32_fp6(w, isc);
            const float tol = am * 0.07f + 1e-30f; bool good = true;
#pragma unroll
            for (int j = 0; j < 32; ++j) good = good && (fabsf(back[j] - v[j >> 2][j & 3]) <= tol);
            ok = __all(good);
        }
#endif
        if (!ok) {
            unsigned ww[6] = {0u, 0u, 0u, 0u, 0u, 0u};
#pragma unroll
            for (int j = 0; j < 32; ++j) { const unsigned c = enc_e2m3(v[j >> 2][j & 3] * sc); const int bp = 6 * j, wd = bp >> 5, of = bp & 31; ww[wd] |= c << of; if (of > 26) ww[wd + 1] |= c >> (32 - of); }
#pragma unroll
            for (int k = 0; k < 6; ++k) w[k] = ww[k];
        }
        GAS unsigned* o = (GAS unsigned*)(dst + (size_t)r * 1536 + lane * 24);
#pragma unroll
        for (int k = 0; k < 6; ++k) o[k] = w[k];
        if (lane == 0) inv[r] = isc;
    }
}
__device__ __forceinline__ unsigned enc_e2m1(float x) {
    const unsigned ub = __builtin_bit_cast(unsigned, x), ua = ub & 0x7fffffffu; const float a = __builtin_bit_cast(float, ua);
    unsigned r;
    if (a >= 1.0f) { const unsigned u = ua + 0x1FFFFFu + ((ua >> 22) & 1u); r = (u >> 22) - (127u << 1) + 2u; }
    else r = (unsigned)__builtin_rintf(a * 2.f);
    r = r > 7u ? 7u : r;
    return r | ((ub >> 28) & 8u);
}
#ifndef FP4_HW
#define FP4_HW 1
#endif
__device__ __forceinline__ void cvt_rows_fp4(const float* src, unsigned char* dst, float* inv, int nrows, int gw, int NGW, int lane) {
    f32x4 nx[8];
    if (gw < nrows) { const GAS f32x4* s = (const GAS f32x4*)(src + (size_t)gw * D) + 2 * lane;
#pragma unroll
        for (int q = 0; q < 4; ++q) { nx[2 * q] = __builtin_nontemporal_load(s + 128 * q); nx[2 * q + 1] = __builtin_nontemporal_load(s + 128 * q + 1); } }
    for (int r = gw; r < nrows; r += NGW) {
        f32x4 v[8]; float am = 0.f;
#pragma unroll
        for (int q = 0; q < 8; ++q) v[q] = nx[q];
        { const int rn = r + NGW; if (rn < nrows) { const GAS f32x4* s = (const GAS f32x4*)(src + (size_t)rn * D) + 2 * lane;
#pragma unroll
            for (int q = 0; q < 4; ++q) { nx[2 * q] = __builtin_nontemporal_load(s + 128 * q); nx[2 * q + 1] = __builtin_nontemporal_load(s + 128 * q + 1); } } }
#pragma unroll
        for (int q = 0; q < 8; ++q) am = fmaxf(am, fmaxf(fmaxf(fabsf(v[q].x), fabsf(v[q].y)), fmaxf(fabsf(v[q].z), fabsf(v[q].w))));
#pragma unroll
        for (int o = 1; o < 64; o <<= 1) am = fmaxf(am, __shfl_xor(am, o));
        float sc, isc; row_scale(am, 6.f, sc, isc);
        unsigned w[4]; bool ok = false;
#if FP4_HW
        {
#pragma unroll
            for (int q = 0; q < 4; ++q) { unsigned t = 0u;
                t = __builtin_amdgcn_cvt_scalef32_pk_fp4_f32(t, v[2 * q].x, v[2 * q].y, isc, 0); t = __builtin_amdgcn_cvt_scalef32_pk_fp4_f32(t, v[2 * q].z, v[2 * q].w, isc, 1);
                t = __builtin_amdgcn_cvt_scalef32_pk_fp4_f32(t, v[2 * q + 1].x, v[2 * q + 1].y, isc, 2); t = __builtin_amdgcn_cvt_scalef32_pk_fp4_f32(t, v[2 * q + 1].z, v[2 * q + 1].w, isc, 3); w[q] = t; }
            const float tol = am * 0.34f + 1e-30f; bool good = true;
#pragma unroll
            for (int bsel = 0; bsel < 4; ++bsel) { const f32x2_t p = (bsel == 0) ? __builtin_amdgcn_cvt_scalef32_pk_f32_fp4(w[1], isc, 0) : (bsel == 1) ? __builtin_amdgcn_cvt_scalef32_pk_f32_fp4(w[1], isc, 1) : (bsel == 2) ? __builtin_amdgcn_cvt_scalef32_pk_f32_fp4(w[1], isc, 2) : __builtin_amdgcn_cvt_scalef32_pk_f32_fp4(w[1], isc, 3);
                const f32x4 o_ = v[2 + (bsel >> 1)]; const float e0 = (bsel & 1) ? o_.z : o_.x, e1 = (bsel & 1) ? o_.w : o_.y;
                good = good && (fabsf(p.x - e0) <= tol) && (fabsf(p.y - e1) <= tol); }
            ok = __all(good);
        }
#endif
        if (!ok) {
#pragma unroll
            for (int q = 0; q < 4; ++q)
                w[q] = enc_e2m1(v[2 * q].x * sc) | (enc_e2m1(v[2 * q].y * sc) << 4) | (enc_e2m1(v[2 * q].z * sc) << 8) | (enc_e2m1(v[2 * q].w * sc) << 12)
                     | (enc_e2m1(v[2 * q + 1].x * sc) << 16) | (enc_e2m1(v[2 * q + 1].y * sc) << 20) | (enc_e2m1(v[2 * q + 1].z * sc) << 24) | (enc_e2m1(v[2 * q + 1].w * sc) << 28);
        }
        GAS unsigned* o = (GAS unsigned*)(dst + (size_t)r * 1024) + lane;
#pragma unroll
        for (int q = 0; q < 4; ++q) o[64 * q] = w[q];
        if (lane == 0) inv[r] = isc;
    }
}
__device__ __forceinline__ void cvt_rows_i4(const float* src, unsigned char* dst, float* inv, int nrows, int gw, int NGW, int lane) {
    f32x4 nx[8];
    if (gw < nrows) { const GAS f32x4* s = (const GAS f32x4*)(src + (size_t)gw * D) + 2 * lane;
#pragma unroll
        for (int q = 0; q < 4; ++q) { nx[2 * q] = __builtin_nontemporal_load(s + 128 * q); nx[2 * q + 1] = __builtin_nontemporal_load(s + 128 * q + 1); } }
    for (int r = gw; r < nrows; r += NGW) {
        f32x4 v[8]; float am = 0.f;
#pragma unroll
        for (int q = 0; q < 8; ++q) v[q] = nx[q];
        { const int rn = r + NGW; if (rn < nrows) { const GAS f32x4* s = (const GAS f32x4*)(src + (size_t)rn * D) + 2 * lane;
#pragma unroll
            for (int q = 0; q < 4; ++q) { nx[2 * q] = __builtin_nontemporal_load(s + 128 * q); nx[2 * q + 1] = __builtin_nontemporal_load(s + 128 * q + 1); } } }
#pragma unroll
        for (int q = 0; q < 8; ++q) am = fmaxf(am, fmaxf(fmaxf(fabsf(v[q].x), fabsf(v[q].y)), fmaxf(fabsf(v[q].z), fabsf(v[q].w))));
#pragma unroll
        for (int o = 1; o < 64; o <<= 1) am = fmaxf(am, __shfl_xor(am, o));
        const bool nz = am > 1e-30f; const float sc = nz ? am * (1.f / 7.f) : 1.f, isc = nz ? 7.f / am : 0.f;
        GAS unsigned* o = (GAS unsigned*)(dst + (size_t)r * 1024) + lane;
#pragma unroll
        for (int q = 0; q < 4; ++q) { unsigned w = 0u;
#pragma unroll
            for (int j = 0; j < 8; ++j) { const float x = v[2 * q + (j >> 2)][j & 3]; const unsigned bits = __builtin_bit_cast(unsigned, __builtin_fmaf(x, isc, 12582912.f));
                w |= (bits & 15u) << (4 * j); }
            o[64 * q] = w; }
        if (lane == 0) inv[r] = sc;
    }
}
__device__ __forceinline__ void peer_tables_rows(Frame& F, int Lt, int tab, int r0, int nrows, int gw, int NGW, int lane) {
    unsigned char* ws = ldws(F);
    const size_t row = (size_t)Lt * NE + r0;
#if U_FP4 && V_FP4
#if U_I4
    if (tab == 0) cvt_rows_i4(ldin(F, 17) + row * D, ws + WS_UT + row * 1024, (float*)(ws + WS_US) + row, nrows, gw, NGW, lane);
    else cvt_rows_fp4(ldin(F, 18) + row * D, ws + WS_VT + row * 1024, (float*)(ws + WS_VS) + row, nrows, gw, NGW, lane);
#else
    const float* src = (tab == 0 ? ldin(F, 17) : ldin(F, 18)) + row * D;
    cvt_rows_fp4(src, ws + (tab == 0 ? WS_UT : WS_VT) + row * 1024, (float*)(ws + (tab == 0 ? WS_US : WS_VS)) + row, nrows, gw, NGW, lane);
#endif
#else
    if (tab == 0) {
#if U_FP4
        cvt_rows_fp4(ldin(F, 17) + row * D, ws + WS_UT + row * 1024, (float*)(ws + WS_US) + row, nrows, gw, NGW, lane);
#else
        cvt_rows_fp6(ldin(F, 17) + row * D, ws + WS_UT + row * 1536, (float*)(ws + WS_US) + row, nrows, gw, NGW, lane);
#endif
    } else {
#if V_FP4
        cvt_rows_fp4(ldin(F, 18) + row * D, ws + WS_VT + row * 1024, (float*)(ws + WS_VS) + row, nrows, gw, NGW, lane);
#else
        cvt_rows_fp6(ldin(F, 18) + row * D, ws + WS_VT + row * 1536, (float*)(ws + WS_VS) + row, nrows, gw, NGW, lane);
#endif
    }
#endif
}
__device__ __forceinline__ void peer_tables_fill(Frame& F, int Lt, unsigned* qhead) {
    const int lane = lane_id();
    volatile LAS unsigned* slot = (volatile LAS unsigned*)(F.lds + MISC_OFF) + 17;
    for (;;) {
        __syncthreads();
        if (threadIdx.x == 0) *slot = atomicAdd(qhead, 1u);
        __syncthreads();
        const unsigned c = *slot;
        if (c >= (unsigned)(NE / 128)) break;
        peer_tables_rows(F, Lt, FILL_TAB, (int)c * 128, 128, F.wave, NWAVES, lane);
    }
}
__device__ __forceinline__ void p0_prologue(Frame& F) {
    const int lane = lane_id();
    unsigned char* ws = ldws(F);
    LAS float* scr = (LAS float*)(F.lds + RING_OFF + F.wave * 16384);
    const int gw = F.vcu * NWAVES + F.wave, NGW = F.G * NWAVES;
    constexpr int I_A = (D / 64) * (A_QKV / 32), I_B = (D / 64) * (B_QKV / 32), I_O = (D / 64) * (D / 32);
    constexpr int NITEMS = 2 * I_A + 2 * I_B + 4 * I_O;
    for (int rp = 0; rp < ((P0_RPT & 2) ? 2 : 1); ++rp)
    for (int it = gw; it < NITEMS; it += NGW) {
        int r = it;
        if (r < 2 * I_A) { const int j = r / I_A; p0_transpose_item(ldin(F, 1) + (size_t)j * D * A_QKV, D, A_QKV, (bf16*)(ws + WS_WQKVA) + (size_t)j * A_QKV * D, scr, r % I_A, lane); continue; } r -= 2 * I_A;
        if (r < 2 * I_B) { const int j = r / I_B; p0_transpose_item(ldin(F, 4) + (size_t)j * D * B_QKV, D, B_QKV, (bf16*)(ws + WS_WQKVB) + (size_t)j * B_QKV * D, scr, r % I_B, lane); continue; } r -= 2 * I_B;
        { const int L = r / I_O, j = L >> 1; const float* W = ((L & 1) ? ldin(F, 10) : ldin(F, 3)) + (size_t)j * D * D; p0_transpose_item(W, D, D, (bf16*)(ws + WS_WO) + (size_t)L * D * D, scr, r % I_O, lane); }
    }
    for (int R = gw; R < DEPTH * 2048; R += NGW) {
        const int hc = (R >> 7) & 15; const float* src = ldin(F, 16) + (size_t)R * 128;
        GAS v4u* drow = (GAS v4u*)((bf16*)(ws + WS_ABLK) + (size_t)R * 2048);
#pragma unroll
        for (int j = 0; j < 4; ++j) { const int p = lane + 64 * j; v4u o = {0u, 0u, 0u, 0u};
            if ((p >> 4) == hc) { const f32x4 a = *(const GAS f32x4*)(src + (p & 15) * 8), b = *(const GAS f32x4*)(src + (p & 15) * 8 + 4); o.x = pkbf(a.x, a.y); o.y = pkbf(a.z, a.w); o.z = pkbf(b.x, b.y); o.w = pkbf(b.z, b.w); }
            drow[p] = o; }
    }
    const size_t gt = (size_t)gw * 64 + lane, GT = (size_t)NGW * 64;
    cvt_stream(ldin(F, 15), (bf16*)(ws + WS_WQB), (size_t)DEPTH * D * 2048 / 8, gt, GT);
    cvt_stream(ldin(F, 0), (bf16*)(ws + WS_XB), (size_t)T * D / 8, gt, GT);
    for (int rp = 0; rp < ((P0_RPT & 1) ? 2 : 1); ++rp)
    for (int Lt = 0; Lt < DEPTH; ++Lt) {
        if (!(TABLE_FILL && (Lt & 1) && FILL_TAB == 0)) peer_tables_rows(F, Lt, 0, 0, NE, gw, NGW, lane);
        if (!(TABLE_FILL && (Lt & 1) && FILL_TAB == 1)) peer_tables_rows(F, Lt, 1, 0, NE, gw, NGW, lane);
    }
}


__device__ __forceinline__ void p1_simple(Frame& F) {
    const int lane = lane_id(); unsigned char* ws = ldws(F);
    const int gw = F.vcu * NWAVES + F.wave, NGW = F.G * NWAVES;
    const float* sk = ldin(F, 16); const float* wq = ldin(F, 15); bf16* weff = (bf16*)(ws + WS_WEFF);
    for (int it = gw; it < DEPTH * 2048 * 32; it += NGW) {
        const int R = it >> 5, ib = it & 31, L = R >> 11, hc = (R >> 7) & 15, i = ib * 64 + lane;
        const GAS f32x4* s4 = (const GAS f32x4*)(sk + (size_t)R * 128);
        const GAS f32x4* w4 = (const GAS f32x4*)(wq + ((size_t)L * 2048 + i) * 2048 + hc * 128);
        float acc = 0.f;
#pragma unroll 8
        for (int d = 0; d < 32; ++d) { const f32x4 a = s4[d], b = w4[d]; acc += a.x * b.x + a.y * b.y + a.z * b.z + a.w * b.w; }
        const unsigned pk = pkbf(acc, 0.f);
        *(GAS unsigned short*)(weff + (size_t)R * 2048 + i) = (unsigned short)(pk & 0xffffu);
    }
}

__device__ __forceinline__ void p1b_vectors(Frame& F) {
    const int lane = lane_id(); unsigned char* ws = ldws(F);
    const int gw = F.vcu * NWAVES + F.wave, NGW = F.G * NWAVES;
    const float* g1 = ldin(F, 11); const float* b1 = ldin(F, 12);
    for (int it = gw; it < DEPTH * 2048; it += NGW) { const int L = it >> 11;
        const GAS v4u* wr = (const GAS v4u*)((const bf16*)(ws + WS_WEFF) + (size_t)it * 2048);
        float c = 0.f, b = 0.f;
#pragma unroll
        for (int j = 0; j < 4; ++j) { const v4u w = wr[lane + 64 * j]; const GAS f32x4* gp = (const GAS f32x4*)(g1 + L * D + 8 * (lane + 64 * j)); const GAS f32x4* bp = (const GAS f32x4*)(b1 + L * D + 8 * (lane + 64 * j));
            const f32x4 ga = gp[0], gb = gp[1], ba = bp[0], bb = bp[1];
            const float w0 = bf_lo(w.x), w1 = bf_hi(w.x), w2 = bf_lo(w.y), w3 = bf_hi(w.y), w4 = bf_lo(w.z), w5 = bf_hi(w.z), w6 = bf_lo(w.w), w7 = bf_hi(w.w);
            c += (w0 * ga.x + w1 * ga.y) + (w2 * ga.z + w3 * ga.w) + (w4 * gb.x + w5 * gb.y) + (w6 * gb.z + w7 * gb.w);
            b += (w0 * ba.x + w1 * ba.y) + (w2 * ba.z + w3 * ba.w) + (w4 * bb.x + w5 * bb.y) + (w6 * bb.z + w7 * bb.w); }
        c = wave_sum(c); b = wave_sum(b);
        if (lane == 0) { ((float*)(ws + WS_CSW))[it] = c; ((float*)(ws + WS_CSW))[DEPTH * 2048 + it] = b; }
    }
}

__device__ __forceinline__ void ln_phase(Frame& F, const float* y, const float* g, const float* b, float* xf, bf16* xb) {
    const int lane = lane_id();
    const int gw = F.vcu * NWAVES + F.wave, NGW = F.G * NWAVES;
    for (int m = gw; m < T; m += NGW) {
        const GAS f32x4* yr = (const GAS f32x4*)(y + (size_t)m * D) + lane;
        f32x4 v[8]; float s = 0.f;
#pragma unroll
        for (int j = 0; j < 8; ++j) { v[j] = yr[64 * j]; s += (v[j].x + v[j].y) + (v[j].z + v[j].w); }
        const float mean = wave_sum(s) * (1.f / D); float s2 = 0.f;
#pragma unroll
        for (int j = 0; j < 8; ++j) { v[j] = v[j] - mean; s2 += (v[j].x * v[j].x + v[j].y * v[j].y) + (v[j].z * v[j].z + v[j].w * v[j].w); }
        const float rstd = 1.f / sqrtf(wave_sum(s2) * (1.f / D) + LN_EPS);
        GAS f32x4* of = (GAS f32x4*)(xf + (size_t)m * D) + lane; GAS v2u* ob = (GAS v2u*)(xb + (size_t)m * D) + lane;
#pragma unroll
        for (int j = 0; j < 8; ++j) { const f32x4 gg = ((const GAS f32x4*)g)[lane + 64 * j], bb = ((const GAS f32x4*)b)[lane + 64 * j];
            const f32x4 o = v[j] * rstd * gg + bb; of[64 * j] = o; v2u w; w.x = pkbf(o.x, o.y); w.y = pkbf(o.z, o.w); ob[64 * j] = w; }
    }
}

__device__ __forceinline__ int crow(int r, int hi) { return (r & 3) + 8 * (r >> 2) + 4 * hi; }
__device__ __forceinline__ s16x4 vtr(const LAS unsigned char* p) { return __builtin_bit_cast(s16x4, __builtin_amdgcn_ds_read_tr16_b64_v4i16((LAS s16x4*)p)); }
__device__ __forceinline__ bf16x8 cat8(s16x4 a, s16x4 b) { return __builtin_shufflevector(a, b, 0, 1, 2, 3, 4, 5, 6, 7); }
__device__ __forceinline__ float xhalf(float v) { return __shfl_xor(v, 32); }
__device__ __forceinline__ float xhalf_max(float v) { float a = v, b = v; asm volatile("s_nop 1\n\tv_permlane32_swap_b32 %0, %1\n\ts_nop 1" : "+v"(a), "+v"(b)); return fmaxf(a, b); }
__device__ __forceinline__ float xhalf_sum(float v) { float a = v, b = v; asm volatile("s_nop 1\n\tv_permlane32_swap_b32 %0, %1\n\ts_nop 1" : "+v"(a), "+v"(b)); return a + b; }

__device__ __forceinline__ void swa_unit(Frame& F, const bf16* qkv, bf16* ob, const float* sinks, int nb, int g) {
    LAS unsigned char* lds = F.lds + RING_OFF;
    const int lane_ = lane_id();
    const int lane = lane_, w = F.wave, hh = lane >> 5, n = lane & 31;
    __syncthreads();
#pragma unroll
    for (int i = 0; i < 4; ++i) {
        const int P = w + 8 * i;
        { const int key = 8 * P + (lane & 7), ch = lane >> 3, tok = (nb - 1) * 128 + key; v4u v = {0u, 0u, 0u, 0u};
          if (tok >= 0) v = *(const GAS v4u*)(qkv + (size_t)tok * A_QKV + 2048 + g * 64 + ch * 8);
          *(LAS v4u*)(lds + ch * 4096 + key * 16) = v; }
        { const int key = 8 * P + (lane >> 3), ch = lane & 7, tok = (nb - 1) * 128 + key; v4u v = {0u, 0u, 0u, 0u};
          if (tok >= 0) v = *(const GAS v4u*)(qkv + (size_t)tok * A_QKV + 2304 + g * 64 + ch * 8);
          *(LAS v4u*)(lds + 32768 + (ch >> 2) * 16384 + key * 64 + (ch & 3) * 16) = v; }
    }
    __syncthreads();
    const int hq = 8 * g + w;
    const float slope2 = exp2f(-0.25f * (float)(hq + 1)) * LOG2E;
    const float sink2 = sinks[hq] * LOG2E;
    const int G16 = lane >> 4, vq = (lane & 15) >> 2, vp = lane & 3;
    for (int qs = 0; qs < 4; ++qs) {
        const int qi = 32 * qs + n; const size_t tok = (size_t)nb * 128 + qi;
        bf16x8 qf[4];
#pragma unroll
        for (int s = 0; s < 4; ++s) qf[s] = *(const GAS bf16x8*)(qkv + tok * A_QKV + hq * 64 + 16 * s + 8 * hh);
        f32x16 t[5];
#pragma unroll
        for (int i = 0; i < 5; ++i) {
#pragma unroll
            for (int r = 0; r < 16; ++r) t[i][r] = 0.f;
#pragma unroll
            for (int s = 0; s < 4; ++s) { const bf16x8 a = *(const LAS bf16x8*)(lds + (2 * s + hh) * 4096 + (32 * (qs + i) + n) * 16); t[i] = MFMA32(a, qf[s], t[i]); }
        }
        float mx = sink2;
#pragma unroll
        for (int i = 0; i < 5; ++i)
#pragma unroll
            for (int r = 0; r < 16; ++r) { const int cr = (r & 3) + 8 * (r >> 2); const int dist = (128 + qi - 32 * (qs + i) - 4 * hh) - cr;
                const bool valid = (dist >= 0) && (dist < 128) && (nb > 0 || dist <= qi);
                const float s2 = valid ? (t[i][r] - slope2 * (float)dist) : NEGBIG; t[i][r] = s2; mx = fmaxf(mx, s2); }
        mx = xhalf_max(mx);
        float sum = 0.f;
#pragma unroll
        for (int i = 0; i < 5; ++i)
#pragma unroll
            for (int r = 0; r < 16; ++r) { const float p = __builtin_amdgcn_exp2f(t[i][r] - mx); t[i][r] = p; sum += p; }
        sum = xhalf_sum(sum); sum += __builtin_amdgcn_exp2f(sink2 - mx);
        const float inv = 1.f / sum;
        f32x16 o[2];
#pragma unroll
        for (int db = 0; db < 2; ++db)
#pragma unroll
            for (int r = 0; r < 16; ++r) o[db][r] = 0.f;
#pragma unroll
        for (int i = 0; i < 5; ++i)
#pragma unroll
            for (int ks = 0; ks < 2; ++ks) {
                bf16x8 pf; { v4u u; u.x = pkbf(t[i][8 * ks + 0], t[i][8 * ks + 1]); u.y = pkbf(t[i][8 * ks + 2], t[i][8 * ks + 3]); u.z = pkbf(t[i][8 * ks + 4], t[i][8 * ks + 5]); u.w = pkbf(t[i][8 * ks + 6], t[i][8 * ks + 7]); pf = __builtin_bit_cast(bf16x8, u); }
                const int key0 = 32 * (qs + i) + 16 * ks + 4 * hh + vq;
#pragma unroll
                for (int db = 0; db < 2; ++db) { const LAS unsigned char* vb = lds + 32768 + db * 16384 + key0 * 64 + (16 * (G16 & 1) + 4 * vp) * 2;
                    const bf16x8 a = cat8(vtr(vb), vtr(vb + 8 * 64)); o[db] = MFMA32(a, pf, o[db]); }
            }
        bf16* orow = ob + tok * D + hq * 64;
#pragma unroll
        for (int db = 0; db < 2; ++db)
#pragma unroll
            for (int r4 = 0; r4 < 4; ++r4) { v2u u; u.x = pkbf(o[db][4 * r4] * inv, o[db][4 * r4 + 1] * inv); u.y = pkbf(o[db][4 * r4 + 2] * inv, o[db][4 * r4 + 3] * inv);
                *(GAS v2u*)(orow + 32 * db + 8 * r4 + 4 * hh) = u; }
    }
}

constexpr int DA_STAGE = 24576, DA_NS = 4;
constexpr float DA_THR = 8.f;
#define DA_WAIT_BAR(N) asm volatile("s_waitcnt vmcnt(" #N ")\n\ts_barrier" ::: "memory")
__device__ __forceinline__ void da_issue(const bf16* kg, const bf16* vg0, const bf16* vg1, int kt, LAS unsigned char* st, int w) {
    const size_t ro = (size_t)kt * 64 * B_QKV;
    __builtin_amdgcn_global_load_lds((const unsigned*)(kg + ro), (LAS unsigned*)(st + w * 1024), 16, 0, 0);
    __builtin_amdgcn_global_load_lds((const unsigned*)(vg0 + ro), (LAS unsigned*)(st + 8192 + (2 * w) * 1024), 16, 0, 0);
    __builtin_amdgcn_global_load_lds((const unsigned*)(vg1 + ro), (LAS unsigned*)(st + 8192 + (2 * w + 1) * 1024), 16, 0, 0);
}
template <int OFF> __device__ __forceinline__ v2u ds_tr(unsigned addr) { v2u r; asm volatile("ds_read_b64_tr_b16 %0, %1 offset:%2" : "=v"(r) : "v"(addr), "n"(OFF)); return r; }
#define DA_FOFF(j) ((((j) & 3) * 4096) + (((j) >> 2) * 1024))
#define DA_RD(j, lo, hi) lo = ds_tr<DA_FOFF(j)>(sva); hi = ds_tr<DA_FOFF(j) + 512>(sva)
#define DA_MM(j, lo, hi, N) asm volatile("s_waitcnt lgkmcnt(" #N ")" : "+v"(lo), "+v"(hi)); o[(j) & 3] = MFMA32(__builtin_bit_cast(bf16x8, __builtin_shufflevector(lo, hi, 0, 1, 2, 3)), pf[(j) >> 2], o[(j) & 3])
__device__ __forceinline__ void da_pv(f32x16 (&o)[4], const bf16x8 (&pf)[4], const LAS unsigned char* sv) {
    const unsigned sva = (unsigned)(size_t)sv;
    v2u al, ah, bl, bh;
    DA_RD(0, al, ah); DA_RD(1, bl, bh);
    DA_MM(0, al, ah, 2);  DA_RD(2, al, ah);   DA_MM(1, bl, bh, 2);  DA_RD(3, bl, bh);
    DA_MM(2, al, ah, 2);  DA_RD(4, al, ah);   DA_MM(3, bl, bh, 2);  DA_RD(5, bl, bh);
    DA_MM(4, al, ah, 2);  DA_RD(6, al, ah);   DA_MM(5, bl, bh, 2);  DA_RD(7, bl, bh);
    DA_MM(6, al, ah, 2);  DA_RD(8, al, ah);   DA_MM(7, bl, bh, 2);  DA_RD(9, bl, bh);
    DA_MM(8, al, ah, 2);  DA_RD(10, al, ah);  DA_MM(9, bl, bh, 2);  DA_RD(11, bl, bh);
    DA_MM(10, al, ah, 2); DA_RD(12, al, ah);  DA_MM(11, bl, bh, 2); DA_RD(13, bl, bh);
    DA_MM(12, al, ah, 2); DA_RD(14, al, ah);  DA_MM(13, bl, bh, 2); DA_RD(15, bl, bh);
    DA_MM(14, al, ah, 2); DA_MM(15, bl, bh, 0);
}

__device__ __forceinline__ void da_norms(Frame& F, const bf16* qkv, unsigned* bnd  ) {
    const int lane = lane_id(); const int gw = F.vcu * NWAVES + F.wave, NGW = F.G * NWAVES;
    float mq[4] = {0.f, 0.f, 0.f, 0.f}, mk[4] = {0.f, 0.f, 0.f, 0.f};
    for (int t = gw; t < T; t += NGW) {
#pragma unroll
        for (int j = 0; j < 4; ++j) {
            const v4u a = *(const GAS v4u*)(qkv + (size_t)t * B_QKV + 512 * j + 8 * lane), b = *(const GAS v4u*)(qkv + (size_t)t * B_QKV + 2048 + 512 * j + 8 * lane);
            float sa = 0.f, sb = 0.f;
#pragma unroll
            for (int e = 0; e < 4; ++e) { const float x0 = bf_lo(a[e]), x1 = bf_hi(a[e]), y0 = bf_lo(b[e]), y1 = bf_hi(b[e]); sa += x0 * x0 + x1 * x1; sb += y0 * y0 + y1 * y1; }
            sa += __shfl_xor(sa, 1); sa += __shfl_xor(sa, 2); sa += __shfl_xor(sa, 4); sb += __shfl_xor(sb, 1); sb += __shfl_xor(sb, 2); sb += __shfl_xor(sb, 4);
            mq[j] = fmaxf(mq[j], sa); mk[j] = fmaxf(mk[j], sb);
        }
    }
    LAS unsigned* red = (LAS unsigned*)(F.lds + RING_OFF + 99 * 1024);
    if (threadIdx.x < 32) red[threadIdx.x] = 0u;
    __syncthreads();
    if ((lane & 7) == 0) {
#pragma unroll
        for (int j = 0; j < 4; ++j) { const int hd = (8 * j + (lane >> 3)) >> 1; __hip_atomic_fetch_max(red + hd, __builtin_bit_cast(unsigned, mq[j]), __ATOMIC_RELAXED, __HIP_MEMORY_SCOPE_WORKGROUP); __hip_atomic_fetch_max(red + 16 + hd, __builtin_bit_cast(unsigned, mk[j]), __ATOMIC_RELAXED, __HIP_MEMORY_SCOPE_WORKGROUP); }
    }
    __syncthreads();
    if (threadIdx.x < 32) atomicMax(bnd + threadIdx.x, red[threadIdx.x]);
}
__device__ __forceinline__ void dattn_unit(Frame& F, const bf16* qkv, bf16* ob, float* stash, const float* subg, float lam, float outscale, int h, int qb, int kt_lo, int kt_hi, int part, float* pO, float* pS) {
    LAS unsigned char* lds = F.lds + RING_OFF;
    const int lane_ = lane_id();
    const int lane = lane_, w = F.wave, hh = lane >> 5, n = lane & 31;
    const int q0 = 256 * qb, q0w = q0 + 32 * w;
    const float slope2 = exp2f(-0.5f * (float)(h + 1)) * LOG2E;
    const int G16 = lane >> 4, vq = (lane & 15) >> 2, vp = lane & 3;
    const int nkt = kt_hi - kt_lo;
    const int ktw = (q0w + 31) >> 6;
    f32x16 br;
#pragma unroll
    for (int r = 0; r < 16; ++r) br[r] = slope2 * (float)crow(r, hh);
    float* mystash = stash + (size_t)(w * 64 + lane) * 64;
    int kad[4];
#pragma unroll
    for (int s = 0; s < 4; ++s) kad[s] = n * 128 + (((2 * s + hh) ^ ((n >> 1) & 7)) * 16);
    const int vad = 8192 + (4 * hh + vq) * 64 + (16 * (G16 & 1) + 4 * vp) * 2;
#pragma unroll 1
    for (int c = 0; c < 2; ++c) {
        const bf16* kg; const bf16* vg0; const bf16* vg1;
        { const int key = 8 * w + (lane >> 3), ch = (lane & 7) ^ ((key >> 1) & 7); kg = qkv + (size_t)key * B_QKV + 2048 + h * 128 + c * 64 + ch * 8; }
        { const int j0 = 2 * w, j1 = 2 * w + 1; const int k0_ = 16 * (j0 & 3) + (lane >> 2), k1_ = 16 * (j1 & 3) + (lane >> 2);
          vg0 = qkv + (size_t)k0_ * B_QKV + 4096 + h * 128 + (j0 >> 2) * 32 + (lane & 3) * 8; vg1 = qkv + (size_t)k1_ * B_QKV + 4096 + h * 128 + (j1 >> 2) * 32 + (lane & 3) * 8; }
        bf16x8 qf[4];
#pragma unroll
        for (int s = 0; s < 4; ++s) qf[s] = *(const GAS bf16x8*)(qkv + (size_t)(q0w + n) * B_QKV + h * 128 + c * 64 + 16 * s + 8 * hh);
        f32x16 o[4];
#pragma unroll
        for (int db = 0; db < 4; ++db)
#pragma unroll
            for (int r = 0; r < 16; ++r) o[db][r] = 0.f;
        float mref = NEGBIG, lsum = 0.f;
        asm volatile("s_waitcnt vmcnt(0)" ::: "memory");
        __syncthreads();
        da_issue(kg, vg0, vg1, kt_lo + nkt - 1, lds, w);
        da_issue(kg, vg0, vg1, nkt >= 2 ? kt_lo + nkt - 2 : kt_lo, lds + DA_STAGE, w);
        const bool late = (w >= 4);
        bf16x8 pfs[4]; bool have = false;
#pragma unroll
        for (int ks = 0; ks < 4; ++ks) pfs[ks] = (bf16x8){0, 0, 0, 0, 0, 0, 0, 0};
#pragma unroll 1
        for (int it = 0; it <= nkt; ++it) {
            const int kt = kt_lo + nkt - 1 - it;
            const int sti = (it % DA_NS) * DA_STAGE;
            DA_WAIT_BAR(3);
            { const int ktn = kt - 2; da_issue(kg, vg0, vg1, ktn >= kt_lo ? ktn : kt_lo, lds + ((it + 2) % DA_NS) * DA_STAGE, w); }
            if (late && have) {
                da_pv(o, pfs, lds + ((it + DA_NS - 1) % DA_NS) * DA_STAGE + vad);
                have = false;
            }
            if (kt >= kt_lo && kt <= ktw) {
                const LAS unsigned char* st = lds + sti;
                f32x16 t0 = br, t1 = br;
                { bf16x8 kf[8];
#pragma unroll
                  for (int s = 0; s < 4; ++s) { kf[2 * s] = *(const LAS bf16x8*)(st + kad[s]); kf[2 * s + 1] = *(const LAS bf16x8*)(st + kad[s] + 4096); }
                  __builtin_amdgcn_sched_barrier(0);
#pragma unroll
                  for (int s = 0; s < 4; ++s) { t0 = MFMA32(kf[2 * s], qf[s], t0); t1 = MFMA32(kf[2 * s + 1], qf[s], t1); } }
                const float ct0 = slope2 * (float)(64 * kt - q0w), ct1 = ct0 + 32.f * slope2;
                if (64 * kt + 63 > q0w) {
                    const int dq4 = q0w + n - 64 * kt - 4 * hh;
#pragma unroll
                    for (int r = 0; r < 16; ++r) { const int cr = (r & 3) + 8 * (r >> 2); t0[r] = (cr <= dq4) ? t0[r] : NEGBIG; t1[r] = (cr + 32 <= dq4) ? t1[r] : NEGBIG; }
                }
                float m0 = t0[0], m1 = t1[0];
#pragma unroll
                for (int r = 1; r < 16; ++r) { m0 = fmaxf(m0, t0[r]); m1 = fmaxf(m1, t1[r]); }
                float mloc = fmaxf(m0 + ct0, m1 + ct1); mloc = xhalf_max(mloc);
                if (__any(mloc > mref + DA_THR)) {
                    const float mnew = fmaxf(mref, mloc), al = __builtin_amdgcn_exp2f(mref - mnew);
                    lsum *= al;
#pragma unroll
                    for (int db = 0; db < 4; ++db)
#pragma unroll
                        for (int r = 0; r < 16; ++r) o[db][r] *= al;
                    mref = mnew;
                }
                const float s0 = mref - ct0, s1 = mref - ct1;
#pragma unroll
                for (int r = 0; r < 16; ++r) { t0[r] = __builtin_amdgcn_exp2f(t0[r] - s0); t1[r] = __builtin_amdgcn_exp2f(t1[r] - s1); lsum += t0[r] + t1[r]; }
#pragma unroll
                for (int ks = 0; ks < 4; ++ks) { v4u u;
                    if (ks < 2) { u.x = pkbf(t0[8 * ks + 0], t0[8 * ks + 1]); u.y = pkbf(t0[8 * ks + 2], t0[8 * ks + 3]); u.z = pkbf(t0[8 * ks + 4], t0[8 * ks + 5]); u.w = pkbf(t0[8 * ks + 6], t0[8 * ks + 7]); }
                    else { const int k2 = ks - 2; u.x = pkbf(t1[8 * k2 + 0], t1[8 * k2 + 1]); u.y = pkbf(t1[8 * k2 + 2], t1[8 * k2 + 3]); u.z = pkbf(t1[8 * k2 + 4], t1[8 * k2 + 5]); u.w = pkbf(t1[8 * k2 + 6], t1[8 * k2 + 7]); }
                    pfs[ks] = __builtin_bit_cast(bf16x8, u); }
                if (!late) {
                    da_pv(o, pfs, st + vad);
                } else have = true;
            }
        }
        asm volatile("s_waitcnt vmcnt(0)" ::: "memory");
        if (part != 0) {
            float* po = pO + (size_t)c * 32768 + (size_t)(w * 64 + lane) * 64;
#pragma unroll
            for (int db = 0; db < 4; ++db) {
#pragma unroll
                for (int r4 = 0; r4 < 4; ++r4) { f32x4 v = {o[db][4 * r4], o[db][4 * r4 + 1], o[db][4 * r4 + 2], o[db][4 * r4 + 3]}; *(GAS f32x4*)(po + db * 16 + r4 * 4) = v; }
                asm volatile("" ::: "memory"); }
            float* ps = pS + (size_t)c * 1024 + (size_t)(w * 64 + lane) * 2; ps[0] = mref; ps[1] = lsum;
            continue;
        }
        lsum = xhalf_sum(lsum);
        const float inv = 1.f / lsum;
        if (c == 0) {
#pragma unroll
            for (int db = 0; db < 4; ++db) {
#pragma unroll
                for (int r4 = 0; r4 < 4; ++r4) { f32x4 v = {o[db][4 * r4] * inv, o[db][4 * r4 + 1] * inv, o[db][4 * r4 + 2] * inv, o[db][4 * r4 + 3] * inv}; asm volatile("" : "+v"(v)); *(GAS f32x4*)(mystash + db * 16 + r4 * 4) = v; }
                asm volatile("" ::: "memory"); }
        } else {
            VM_WAIT();
            float ss = 0.f;
#pragma unroll
            for (int db = 0; db < 4; ++db) {
#pragma unroll
                for (int r4 = 0; r4 < 4; ++r4) { const f32x4 a = __builtin_nontemporal_load((const GAS f32x4*)(mystash + db * 16 + r4 * 4));
#pragma unroll
                    for (int e = 0; e < 4; ++e) { const float d = a[e] - lam * (o[db][4 * r4 + e] * inv); o[db][4 * r4 + e] = d; ss += d * d; } }
                asm volatile("" : "+v"(o[db]), "+v"(ss) :: "memory"); }
            ss = xhalf_sum(ss);
            const float rn = 1.f / sqrtf(ss * (1.f / 128.f) + LN_EPS) * outscale;
            bf16* orow = ob + (size_t)(q0w + n) * D + h * 128 + 4 * hh;
            const float* gp = subg + 4 * hh;
#pragma unroll
            for (int db = 0; db < 4; ++db) {
#pragma unroll
                for (int r4 = 0; r4 < 4; ++r4) { const int d0 = 32 * db + 8 * r4; const f32x4 gg = *(const GAS f32x4*)(gp + d0);
                    v2u u; u.x = pkbf(o[db][4 * r4] * rn * gg.x, o[db][4 * r4 + 1] * rn * gg.y); u.y = pkbf(o[db][4 * r4 + 2] * rn * gg.z, o[db][4 * r4 + 3] * rn * gg.w);
                    asm volatile("" : "+v"(u)); *(GAS v2u*)(orow + d0) = u; }
                asm volatile("" ::: "memory"); }
        }
    }
}

__device__ __forceinline__ void da_combine(Frame& F, bf16* ob, const float* pO, const float* pS, const float* subg, float lam, float outscale, int h, int qb) {
    const int lane = lane_id(), w = F.wave, hh = lane >> 5, n = lane & 31;
    const int q0w = 256 * qb + 32 * w;
    const size_t lo = (size_t)(w * 64 + lane) * 64, ls = (size_t)(w * 64 + lane) * 2;
    float fa[2], fb[2], il[2];
#pragma unroll
    for (int c = 0; c < 2; ++c) { const float mA = pS[(0 * 2 + c) * 1024 + ls], lA = pS[(0 * 2 + c) * 1024 + ls + 1], mB = pS[(1 * 2 + c) * 1024 + ls], lB = pS[(1 * 2 + c) * 1024 + ls + 1];
        const float M = fmaxf(mA, mB); fa[c] = __builtin_amdgcn_exp2f(mA - M); fb[c] = __builtin_amdgcn_exp2f(mB - M); float l = lA * fa[c] + lB * fb[c]; l += xhalf(l); il[c] = 1.f / l; }
    f32x16 o[4]; float ss = 0.f;
#pragma unroll
    for (int db = 0; db < 4; ++db) {
#pragma unroll
        for (int r4 = 0; r4 < 4; ++r4) {
            const f32x4 a0 = *(const GAS f32x4*)(pO + (size_t)0 * 32768 + lo + db * 16 + r4 * 4), b0 = *(const GAS f32x4*)(pO + (size_t)2 * 32768 + lo + db * 16 + r4 * 4);
            const f32x4 a1 = *(const GAS f32x4*)(pO + (size_t)1 * 32768 + lo + db * 16 + r4 * 4), b1 = *(const GAS f32x4*)(pO + (size_t)3 * 32768 + lo + db * 16 + r4 * 4);
#pragma unroll
            for (int e = 0; e < 4; ++e) { const float o0 = (a0[e] * fa[0] + b0[e] * fb[0]) * il[0], o1 = (a1[e] * fa[1] + b1[e] * fb[1]) * il[1]; const float dd = o0 - lam * o1; o[db][4 * r4 + e] = dd; ss += dd * dd; } }
        asm volatile("" : "+v"(o[db]), "+v"(ss) :: "memory"); }
    ss = xhalf_sum(ss);
    const float rn = 1.f / sqrtf(ss * (1.f / 128.f) + LN_EPS) * outscale;
    bf16* orow = ob + (size_t)(q0w + n) * D + h * 128 + 4 * hh;
    const float* gp = subg + 4 * hh;
#pragma unroll
    for (int db = 0; db < 4; ++db) {
#pragma unroll
        for (int r4 = 0; r4 < 4; ++r4) { const int d0 = 32 * db + 8 * r4; const f32x4 gg = *(const GAS f32x4*)(gp + d0);
            v2u u; u.x = pkbf(o[db][4 * r4] * rn * gg.x, o[db][4 * r4 + 1] * rn * gg.y); u.y = pkbf(o[db][4 * r4 + 2] * rn * gg.z, o[db][4 * r4 + 3] * rn * gg.w);
            asm volatile("" : "+v"(u)); *(GAS v2u*)(orow + d0) = u; }
        asm volatile("" ::: "memory"); }
}

#define CE(a, b) do { const unsigned _hi = (a) > (b) ? (a) : (b), _lo = (a) > (b) ? (b) : (a); (a) = _hi; (b) = _lo; } while (0)
#define SORT16_DESC(v) do { CE(v[0],v[1]); CE(v[3],v[2]); CE(v[4],v[5]); CE(v[7],v[6]); CE(v[8],v[9]); CE(v[11],v[10]); CE(v[12],v[13]); CE(v[15],v[14]); CE(v[0],v[2]); CE(v[1],v[3]); CE(v[6],v[4]); CE(v[7],v[5]); CE(v[8],v[10]); CE(v[9],v[11]); CE(v[14],v[12]); CE(v[15],v[13]); CE(v[0],v[1]); CE(v[2],v[3]); CE(v[5],v[4]); CE(v[7],v[6]); CE(v[8],v[9]); CE(v[10],v[11]); CE(v[13],v[12]); CE(v[15],v[14]); CE(v[0],v[4]); CE(v[1],v[5]); CE(v[2],v[6]); CE(v[3],v[7]); CE(v[12],v[8]); CE(v[13],v[9]); CE(v[14],v[10]); CE(v[15],v[11]); CE(v[0],v[2]); CE(v[1],v[3]); CE(v[4],v[6]); CE(v[5],v[7]); CE(v[10],v[8]); CE(v[11],v[9]); CE(v[14],v[12]); CE(v[15],v[13]); CE(v[0],v[1]); CE(v[2],v[3]); CE(v[4],v[5]); CE(v[6],v[7]); CE(v[9],v[8]); CE(v[11],v[10]); CE(v[13],v[12]); CE(v[15],v[14]); CE(v[0],v[8]); CE(v[1],v[9]); CE(v[2],v[10]); CE(v[3],v[11]); CE(v[4],v[12]); CE(v[5],v[13]); CE(v[6],v[14]); CE(v[7],v[15]); CE(v[0],v[4]); CE(v[1],v[5]); CE(v[2],v[6]); CE(v[3],v[7]); CE(v[8],v[12]); CE(v[9],v[13]); CE(v[10],v[14]); CE(v[11],v[15]); CE(v[0],v[2]); CE(v[1],v[3]); CE(v[4],v[6]); CE(v[5],v[7]); CE(v[8],v[10]); CE(v[9],v[11]); CE(v[12],v[14]); CE(v[13],v[15]); CE(v[0],v[1]); CE(v[2],v[3]); CE(v[4],v[5]); CE(v[6],v[7]); CE(v[8],v[9]); CE(v[10],v[11]); CE(v[12],v[13]); CE(v[14],v[15]); } while (0)
#define MERGE16_DESC(v) do { CE(v[0],v[8]); CE(v[1],v[9]); CE(v[2],v[10]); CE(v[3],v[11]); CE(v[4],v[12]); CE(v[5],v[13]); CE(v[6],v[14]); CE(v[7],v[15]); CE(v[0],v[4]); CE(v[1],v[5]); CE(v[2],v[6]); CE(v[3],v[7]); CE(v[8],v[12]); CE(v[9],v[13]); CE(v[10],v[14]); CE(v[11],v[15]); CE(v[0],v[2]); CE(v[1],v[3]); CE(v[4],v[6]); CE(v[5],v[7]); CE(v[8],v[10]); CE(v[9],v[11]); CE(v[12],v[14]); CE(v[13],v[15]); CE(v[0],v[1]); CE(v[2],v[3]); CE(v[4],v[5]); CE(v[6],v[7]); CE(v[8],v[9]); CE(v[10],v[11]); CE(v[12],v[13]); CE(v[14],v[15]); } while (0)

__device__ __forceinline__ unsigned f2key(float f) { const unsigned u = __builtin_bit_cast(unsigned, f); return u ^ ((unsigned)((int)u >> 31) | 0x80000000u); }
__device__ __forceinline__ float key2f(unsigned k) { const unsigned m = (unsigned)((int)k >> 31); return __builtin_bit_cast(float, k ^ (0x80000000u | ~m)); }
__device__ __forceinline__ unsigned dpp_xor1(unsigned v) { return (unsigned)__builtin_amdgcn_mov_dpp((int)v, 0xB1, 0xF, 0xF, true); }
__device__ __forceinline__ float gelu_erf(float x) { return 0.5f * x * (1.f + erff(x * 0.70710678118654752f)); }


#if (PROBE_MASK & (64 | 128))
__device__ __forceinline__ float wave_maxf(float v) {
#pragma unroll
    for (int o = 1; o < 64; o <<= 1) v = fmaxf(v, __shfl_xor(v, o));
    return v; }
__device__ __forceinline__ int wave_mini(int v) {
#pragma unroll
    for (int o = 1; o < 64; o <<= 1) { const int t = __shfl_xor(v, o); v = t < v ? t : v; }
    return v; }
__global__ void __launch_bounds__(64) peer_ref_kernel(const unsigned char* wsb, const float* in17, size_t uoff, size_t refoff, int tstride, int nblk) {
    const float* sc = (const float*)(wsb + WS_SC); const float* x1f = (const float*)(wsb + WS_XF); const float* utab = in17 + uoff; unsigned* refbase = (unsigned*)(wsb + refoff);
    __shared__ float TV[32]; __shared__ int TI[32];
    const int lane = threadIdx.x, tok = tstride * blockIdx.x;
    unsigned* RE = refbase + blockIdx.x * 128; float* RG = (float*)(refbase + (size_t)nblk * 128) + blockIdx.x * 128; float* RA = (float*)(refbase + (size_t)nblk * 256) + blockIdx.x * 128;
    for (int h = 0; h < 8; ++h) {
        for (int c = 0; c < 2; ++c) {
            const float* s = sc + (size_t)tok * 2048 + (h * 2 + c) * 128;
            float v0 = s[lane], v1 = s[lane + 64];
            for (int r = 0; r < 16; ++r) {
                const float m = wave_maxf(fmaxf(v0, v1));
                const int cand = (v0 == m) ? lane : ((v1 == m) ? lane + 64 : 999);
                const int idx = wave_mini(cand);
                if (lane == 0) { TV[c * 16 + r] = m; TI[c * 16 + r] = idx; }
                if (idx == lane) v0 = -3e38f; if (idx == lane + 64) v1 = -3e38f;
            }
        }
        __syncthreads();
        float cs[4];
        for (int q = 0; q < 4; ++q) { const int p = lane + 64 * q; cs[q] = TV[p >> 4] + TV[16 + (p & 15)]; }
        float bestv[16]; int beste[16];
        for (int r = 0; r < 16; ++r) {
            const float lm = fmaxf(fmaxf(cs[0], cs[1]), fmaxf(cs[2], cs[3]));
            const float m = wave_maxf(lm);
            int cand = 9999;
            for (int q = 3; q >= 0; --q) if (cs[q] == m) cand = lane + 64 * q;
            const int p = wave_mini(cand);
            for (int q = 0; q < 4; ++q) if (p == lane + 64 * q) cs[q] = -3e38f;
            bestv[r] = m; beste[r] = TI[p >> 4] * 128 + TI[16 + (p & 15)];
        }
        float ssum = 0.f;
        for (int r = 0; r < 16; ++r) ssum += __expf(bestv[r] - bestv[0]);
        for (int r = 0; r < 16; ++r) {
            const float g = __expf(bestv[r] - bestv[0]) / ssum;
            const float* ur = utab + (size_t)beste[r] * D; const float* xr = x1f + (size_t)tok * D;
            float a = 0.f;
            for (int d = lane; d < D; d += 64) a += ur[d] * xr[d];
            a = wave_sum(a);
            if (lane == 0) { RE[h * 16 + r] = (unsigned)beste[r]; RG[h * 16 + r] = g; RA[h * 16 + r] = a; }
        }
        __syncthreads();
    }
}
__global__ void __launch_bounds__(64) peer_cmp_kernel(const unsigned char* wsb) {
    const float* dump = (const float*)(wsb + WS_STASH); const unsigned* refbase = (const unsigned*)(wsb + WS_CTL) + 2048 + 16384; unsigned* cnt = (unsigned*)(wsb + WS_CTL) + 2048;
    const int lane = threadIdx.x, tok = 256 * blockIdx.x;
    const unsigned* RE = refbase + blockIdx.x * 128; const float* RG = (const float*)(refbase + 4096) + blockIdx.x * 128; const float* RA = (const float*)(refbase + 8192) + blockIdx.x * 128;
    const float* dmp = dump + (size_t)tok * 384;
    unsigned be = 0, bg = 0, ba = 0;
    for (int k = lane; k < 128; k += 64) { const bool same = __builtin_bit_cast(unsigned, dmp[k]) == RE[k]; be += same ? 0u : 1u; bg += (fabsf(dmp[128 + k] - RG[k]) > 2e-3f) ? 1u : 0u; ba += (same && fabsf(dmp[256 + k] - RA[k]) > 0.03f) ? 1u : 0u; }
    atomicAdd(cnt + 0, be); atomicAdd(cnt + 1, bg); atomicAdd(cnt + 2, ba); if (lane == 0) atomicAdd(cnt + 3, 1u);
}
#endif

#ifndef SOFT_FP8_DECODE
#define SOFT_FP8_DECODE 0
#endif
__device__ __forceinline__ float dec_e4m3(unsigned b) { const unsigned mag = b & 0x7fu; const float a = mag >= 8u ? __builtin_bit_cast(float, (mag + 0x3C0u) << 20) : (float)mag * 0.001953125f; return (b & 0x80u) ? -a : a; }
__device__ __forceinline__ f32x2_t dec2_e4m3(unsigned w) {
#if SOFT_FP8_DECODE
    f32x2_t r; r.x = dec_e4m3(w & 0xffu); r.y = dec_e4m3((w >> 8) & 0xffu); return r;
#else
    return __builtin_amdgcn_cvt_pk_f32_fp8((int)w, false);
#endif
}

constexpr int PEER_WAVE_LDS = 8192;
constexpr int PEER_LNV_OFF = 8 * PEER_WAVE_LDS;
#define LNV(v, q) (*(const LAS f32x4*)(F.lds + RING_OFF + PEER_LNV_OFF + (v) * 8192 + (q) * 1024 + 16 * lane))
__device__ __forceinline__ void peer_group(Frame& F, LAS unsigned char* wl, int tok0, const _Float16* sc, const bf16* x1f  , const long long* stat1, const float* l1g, const float* l1b, const unsigned char* ut, const unsigned char* vt, const float* us, const float* vs,
                                           const float* lg, const float* lb, float* xf_out, bf16* xb_out, const float hscale, unsigned* diag, const float* utab_f32, const int nstages = 3) {
    const int lane_ = lane_id();
    const int lane = lane_;
    LAS unsigned* Ebuf = (LAS unsigned*)wl; LAS float* Gbuf = (LAS float*)(wl + 2048); LAS float* Hbuf = (LAS float*)(wl + 4096); LAS unsigned char* Ibuf = wl + 6144;
    unsigned run[16];
    {
        const int tt = lane >> 4, hc = lane & 15;
        typedef _Float16 h8 __attribute__((ext_vector_type(8)));
        const GAS h8* sp = (const GAS h8*)(sc + (size_t)(tok0 + tt) * 2048 + hc * 128);
        h8 nx[2]; nx[0] = sp[0]; nx[1] = sp[1];
#pragma unroll 1
        for (int cnk = 0; cnk < 8; ++cnk) {
            unsigned ch[16];
            h8 cur[2]; cur[0] = nx[0]; cur[1] = nx[1];
            { const int nc = cnk < 7 ? cnk + 1 : 7; nx[0] = sp[nc * 2]; nx[1] = sp[nc * 2 + 1]; }
#pragma unroll
            for (int q = 0; q < 2; ++q) { const h8 v = cur[q];
#pragma unroll
                for (int e = 0; e < 8; ++e) ch[8 * q + e] = (f2key((float)v[e]) & ~127u) | (unsigned)(127 - (cnk * 16 + 8 * q + e)); }
            SORT16_DESC(ch);
            if (cnk == 0) {
#pragma unroll
                for (int i = 0; i < 16; ++i) run[i] = ch[i];
            } else {
#pragma unroll
                for (int i = 0; i < 16; ++i) run[i] = run[i] > ch[15 - i] ? run[i] : ch[15 - i];
                MERGE16_DESC(run);
            }
        }
    }
    unsigned res[16];
    {
        const bool odd = lane & 1;
        float av[16], bv[16];
#pragma unroll
        for (int i = 0; i < 16; ++i) { const unsigned mine = run[i], oth = dpp_xor1(mine); const unsigned a = odd ? oth : mine, b = odd ? mine : oth;
            av[i] = key2f(a & ~127u); bv[i] = key2f(b & ~127u);
            Ibuf[lane * 32 + i] = (unsigned char)(127u - (a & 127u)); Ibuf[lane * 32 + 16 + i] = (unsigned char)(127u - (b & 127u)); }
        unsigned c0[16], c1[16], c2[16], c3[16];
#pragma unroll
        for (int i = 0; i < 16; ++i) { c3[i] = 0u; }
#define CAND(idx, i, j) { const unsigned kk = (f2key(av[i] + bv[j]) & ~255u) | (unsigned)(255 - ((i) * 16 + (j))); if ((idx) < 16) c0[(idx) & 15] = kk; else if ((idx) < 32) c1[(idx) & 15] = kk; else if ((idx) < 48) c2[(idx) & 15] = kk; else c3[(idx) & 15] = kk; }
CAND(0,0,0)
CAND(1,0,1)
CAND(2,0,2)
CAND(3,0,3)
CAND(4,0,4)
CAND(5,0,5)
CAND(6,0,6)
CAND(7,0,7)
CAND(8,0,8)
CAND(9,0,9)
CAND(10,0,10)
CAND(11,0,11)
CAND(12,0,12)
CAND(13,0,13)
CAND(14,0,14)
CAND(15,0,15)
CAND(16,1,0)
CAND(17,1,1)
CAND(18,1,2)
CAND(19,1,3)
CAND(20,1,4)
CAND(21,1,5)
CAND(22,1,6)
CAND(23,1,7)
CAND(24,2,0)
CAND(25,2,1)
CAND(26,2,2)
CAND(27,2,3)
CAND(28,2,4)
CAND(29,3,0)
CAND(30,3,1)
CAND(31,3,2)
CAND(32,3,3)
CAND(33,4,0)
CAND(34,4,1)
CAND(35,4,2)
CAND(36,5,0)
CAND(37,5,1)
CAND(38,6,0)
CAND(39,6,1)
CAND(40,7,0)
CAND(41,7,1)
CAND(42,8,0)
CAND(43,9,0)
CAND(44,10,0)
CAND(45,11,0)
CAND(46,12,0)
CAND(47,13,0)
CAND(48,14,0)
CAND(49,15,0)

#undef CAND
        SORT16_DESC(c0); SORT16_DESC(c1); SORT16_DESC(c2); SORT16_DESC(c3);
#pragma unroll
        for (int i = 0; i < 16; ++i) { c0[i] = c0[i] > c1[15 - i] ? c0[i] : c1[15 - i]; c2[i] = c2[i] > c3[15 - i] ? c2[i] : c3[15 - i]; }
        MERGE16_DESC(c0); MERGE16_DESC(c2);
#pragma unroll
        for (int i = 0; i < 16; ++i) res[i] = c0[i] > c2[15 - i] ? c0[i] : c2[15 - i];
        MERGE16_DESC(res);
    }
    LDS_WAIT();
    {
        const int tt = lane >> 4, hd = (lane & 15) >> 1; const bool odd = lane & 1;
        float ev[16]; float ssum = 0.f; const float vmax = key2f(res[0] & ~255u);
#pragma unroll
        for (int r = 0; r < 16; ++r) { ev[r] = __expf(key2f(res[r] & ~255u) - vmax); ssum += ev[r]; }
        const float sinv = 1.f / ssum;
#pragma unroll
        for (int r = 0; r < 16; ++r) {
            const unsigned ci = 255u - (res[r] & 255u), i = ci >> 4, j = ci & 15u;
            const unsigned ia = Ibuf[lane * 32 + i], ib = Ibuf[lane * 32 + 16 + j];
            if (((r >> 3) & 1) == (odd ? 1 : 0)) { Ebuf[tt * 128 + hd * 16 + r] = ia * 128u + ib; Gbuf[tt * 128 + hd * 16 + r] = ev[r] * sinv; }
        }
    }
    LDS_WAIT();
#if (PROBE_MASK & 128)
    {
        LAS float* TV = (LAS float*)(wl + 7168); LAS int* TI = (LAS int*)(wl + 7168 + 128);
#pragma unroll 1
        for (int tt_ = 0; tt_ < 4; ++tt_) {
#pragma unroll 1
            for (int h = 0; h < 8; ++h) {
#pragma unroll 1
                for (int c = 0; c < 2; ++c) {
                    const float* s = sc + (size_t)(tok0 + tt_) * 2048 + (h * 2 + c) * 128;
                    float v0 = s[lane], v1 = s[lane + 64];
#pragma unroll 1
                    for (int r = 0; r < 16; ++r) {
                        const float m = wave_maxf(fmaxf(v0, v1));
                        const int cand = (v0 == m) ? lane : ((v1 == m) ? lane + 64 : 999);
                        const int idx = wave_mini(cand);
                        if (lane == 0) { TV[c * 16 + r] = m; TI[c * 16 + r] = idx; }
                        if (idx == lane) v0 = -3e38f; if (idx == lane + 64) v1 = -3e38f;
                    }
                }
                LDS_WAIT();
                float cs[4];
#pragma unroll
                for (int q = 0; q < 4; ++q) { const int p = lane + 64 * q; cs[q] = TV[p >> 4] + TV[16 + (p & 15)]; }
                float bv0 = 0.f, ssum = 0.f, myv = 0.f; int mye = 0;
#pragma unroll 1
                for (int r = 0; r < 16; ++r) {
                    const float lm = fmaxf(fmaxf(cs[0], cs[1]), fmaxf(cs[2], cs[3]));
                    const float m = wave_maxf(lm);
                    int cand = 9999;
#pragma unroll
                    for (int q = 3; q >= 0; --q) if (cs[q] == m) cand = lane + 64 * q;
                    const int p = wave_mini(cand);
#pragma unroll
                    for (int q = 0; q < 4; ++q) if (p == lane + 64 * q) cs[q] = -3e38f;
                    if (r == 0) bv0 = m;
                    const float ex = __expf(m - bv0); ssum += ex;
                    if (lane == r) { myv = ex; mye = TI[p >> 4] * 128 + TI[16 + (p & 15)]; }
                }
                if (lane < 16) { Ebuf[tt_ * 128 + h * 16 + lane] = (unsigned)mye; Gbuf[tt_ * 128 + h * 16 + lane] = myv / ssum; }
                LDS_WAIT();
            }
        }
    }
    LDS_WAIT();
#endif
#if PEER_BANDS
    {
        constexpr int BSH = (PEER_BANDS == 16) ? 10 : (PEER_BANDS == 8) ? 11 : (PEER_BANDS == 32) ? 9 : 8;
        unsigned e_[4][2]; float g_[4][2];
#pragma unroll
        for (int tt = 0; tt < 4; ++tt)
#pragma unroll
            for (int j = 0; j < 2; ++j) { e_[tt][j] = Ebuf[tt * 128 + lane + 64 * j]; g_[tt][j] = Gbuf[tt * 128 + lane + 64 * j]; }
        LDS_WAIT();
#pragma unroll
        for (int tt = 0; tt < 4; ++tt) {
            const unsigned b0 = e_[tt][0] >> BSH, b1 = e_[tt][1] >> BSH; unsigned pos0 = 0u, pos1 = 0u, basep = 0u;
#pragma unroll 1
            for (unsigned b = 0; b < (unsigned)PEER_BANDS; ++b) {
                const unsigned long long m0 = __ballot(b0 == b), m1 = __ballot(b1 == b);
                const unsigned c0 = (unsigned)__popcll(m0), c1 = (unsigned)__popcll(m1);
                const unsigned r0 = __builtin_amdgcn_mbcnt_hi((unsigned)(m0 >> 32), __builtin_amdgcn_mbcnt_lo((unsigned)m0, 0u)), r1 = __builtin_amdgcn_mbcnt_hi((unsigned)(m1 >> 32), __builtin_amdgcn_mbcnt_lo((unsigned)m1, 0u));
                if (b0 == b) pos0 = basep + r0;
                if (b1 == b) pos1 = basep + c0 + r1;
                basep += c0 + c1;
            }
            Ebuf[tt * 128 + pos0] = e_[tt][0]; Gbuf[tt * 128 + pos0] = g_[tt][0]; Ebuf[tt * 128 + pos1] = e_[tt][1]; Gbuf[tt * 128 + pos1] = g_[tt][1];
        }
        LDS_WAIT();
    }
#endif
#if U_I4 && U_CHUNKED
    LAS float* USb = (LAS float*)(wl + 6144);
    {
#pragma unroll
        for (int i = 0; i < 8; ++i) { const unsigned e_ = Ebuf[lane + 64 * i]; USb[lane + 64 * i] = *(const GAS float*)((const unsigned char*)us + (e_ << 2)); }
        LDS_WAIT();
    }
#endif
    if (nstages < 2) return;
    constexpr int PFU = 16, PFV = 16;
    const unsigned lane16 = 16u * (unsigned)lane;
    const int kl = ((lane >> 5) & 1) * 8 + ((lane >> 4) & 1) * 4 + ((lane >> 3) & 1) * 2 + ((lane >> 2) & 1);
#if U_I4 && U_CHUNKED
    {
        float vsr[8];
#pragma unroll
        for (int i = 0; i < 8; ++i) { const unsigned e_ = Ebuf[lane + 64 * i]; vsr[i] = *(const GAS float*)((const unsigned char*)vs + (e_ << 2)); }
        int xh[4][4], xl[4][4]; float xs[4];
#pragma unroll
        for (int t = 0; t < 4; ++t) {
            const size_t tk = (size_t)(tok0 + t); const GAS v4u* xr = (const GAS v4u*)(x1f + tk * D + 32 * lane);
            const float s1 = (float)stat1[2 * tk] * 2.3283064365386963e-10f, s2 = (float)stat1[2 * tk + 1] * 2.3283064365386963e-10f; const float mu = s1 * (1.f / D), rstd = 1.f / sqrtf(s2 * (1.f / D) - mu * mu + LN_EPS), mr = mu * rstd;
            v4u yw[4];
#pragma unroll
            for (int i = 0; i < 4; ++i) yw[i] = xr[i];
            float xv[32]; float mx = 0.f;
#pragma unroll
            for (int q = 0; q < 8; ++q) { const unsigned w0 = yw[q >> 1][2 * (q & 1)], w1 = yw[q >> 1][2 * (q & 1) + 1]; const f32x4 gq = LNV(0, q), bq = LNV(1, q);
                xv[4 * q] = rstd * bf_lo(w0) + (bq.x - mr * gq.x); xv[4 * q + 1] = rstd * bf_hi(w0) + (bq.y - mr * gq.y); xv[4 * q + 2] = rstd * bf_lo(w1) + (bq.z - mr * gq.z); xv[4 * q + 3] = rstd * bf_hi(w1) + (bq.w - mr * gq.w);
                mx = fmaxf(mx, fmaxf(fmaxf(fabsf(xv[4 * q]), fabsf(xv[4 * q + 1])), fmaxf(fabsf(xv[4 * q + 2]), fabsf(xv[4 * q + 3])))); }
            mx = wave_max_all(mx);
            const float isx = mx > 1e-30f ? 119.f / mx : 0.f; xs[t] = mx * (1.f / 119.f);
#pragma unroll
            for (int d = 0; d < 4; ++d) { unsigned h_ = 0u, l_ = 0u;
#pragma unroll
                for (int j = 0; j < 8; ++j) { const int qi = (int)__builtin_bit_cast(unsigned, __builtin_fmaf(xv[8 * d + j], isx, 12582912.f)) - 0x4B400000; const int hi = (qi + 8) >> 4, lo = qi - (hi << 4);
                    h_ |= ((unsigned)hi & 15u) << (4 * j); l_ |= ((unsigned)lo & 15u) << (4 * j); }
                xh[t][d] = (int)h_; xl[t][d] = (int)l_; }
        }
        v4u ub[16]; float usc[16];
#pragma unroll
        for (int k = 0; k < 16; ++k) { const unsigned e_ = Ebuf[k]; ub[k] = *(const GAS v4u*)(ut + ((e_ << 10) + lane16)); usc[k] = USb[k]; }
#pragma unroll 1
        for (int j = 0; j < 8; ++j) {
#pragma unroll
            for (int t = 0; t < 4; ++t) {
                const int cur = t * 128 + 16 * j;
                const int nxt = (t < 3) ? (t + 1) * 128 + 16 * j : (j < 7 ? 16 * (j + 1) : cur);
                v4u uid[4];
                f32x4 usn[4];
                { const LAS v4u* ip = (const LAS v4u*)(Ebuf + nxt); const LAS f32x4* sp_ = (const LAS f32x4*)(USb + nxt);
#pragma unroll
                  for (int i = 0; i < 4; ++i) { uid[i] = ip[i]; usn[i] = sp_[i]; } }
                float part[16];
#pragma unroll
                for (int k = 0; k < 16; ++k) {
                    { const v4u pk = ub[k]; int aH = 0, aL = 0;
#pragma unroll
                      for (int d4 = 0; d4 < 4; ++d4) { aH = __builtin_amdgcn_sdot8((int)pk[d4], xh[t][d4], aH, false); aL = __builtin_amdgcn_sdot8((int)pk[d4], xl[t][d4], aL, false); }
                      part[k] = (float)(aH * 16 + aL) * usc[k]; }
                    { const unsigned e_ = uid[k >> 2][k & 3]; ub[k] = *(const GAS v4u*)(ut + ((e_ << 10) + lane16)); usc[k] = usn[k >> 2][k & 3]; }
                }
#pragma unroll
                for (int i = 0; i < 8; ++i) part[i] = swapsum32(part[i], part[i + 8]);
#pragma unroll
                for (int i = 0; i < 4; ++i) part[i] = swapsum16(part[i], part[i + 4]);
#pragma unroll
                for (int i = 0; i < 2; ++i) { const bool up = lane & 8; const float snd = up ? part[i] : part[i + 2], kp = up ? part[i + 2] : part[i]; part[i] = kp + xor8f(snd); }
                { const bool up = lane & 4; const float snd = up ? part[0] : part[1], kp = up ? part[1] : part[0]; part[0] = kp + xor4f(snd); }
                part[0] += xor2f(part[0]); part[0] += xor1f(part[0]);
                part[0] *= xs[t];
                if ((lane & 3) == 0) Hbuf[cur + kl] = Gbuf[cur + kl] * gelu_erf(part[0]) * hscale;
            }
        }
        LDS_WAIT();
#pragma unroll
        for (int i = 0; i < 8; ++i) Gbuf[lane + 64 * i] = vsr[i];
    }
#else
    {
#if U_FP4
        v4u ub[PFU]; float usc[PFU];
#pragma unroll
        for (int j = 0; j < PFU; ++j) { const unsigned e_ = Ebuf[j]; ub[j] = *(const GAS v4u*)(ut + (size_t)e_ * 1024 + 16 * lane); usc[j] = us[e_]; }
#else
        v3u ub[PFU][2]; float usc[PFU];
#pragma unroll
        for (int j = 0; j < PFU; ++j) { const unsigned e_ = Ebuf[j]; const unsigned char* p = ut + (size_t)e_ * 1536 + 24 * lane; ub[j][0] = *(const GAS v3u*)p; ub[j][1] = *(const GAS v3u*)(p + 12); usc[j] = us[e_]; }
#endif
        f32x2_t xf2[16];
#if U_I4
        int xh[4], xl[4]; float xscale = 0.f;
#endif
#pragma unroll 1
        for (int base = 0; base < 512; base += 16) {
            if ((base & 127) == 0) { const size_t tk = (size_t)(tok0 + (base >> 7)); const GAS v4u* xr = (const GAS v4u*)(x1f + tk * D + 32 * lane);
                const float s1 = (float)stat1[2 * tk] * 2.3283064365386963e-10f, s2 = (float)stat1[2 * tk + 1] * 2.3283064365386963e-10f; const float mu = s1 * (1.f / D), rstd = 1.f / sqrtf(s2 * (1.f / D) - mu * mu + LN_EPS), mr = mu * rstd;
                v4u yw[4];
#pragma unroll
                for (int i = 0; i < 4; ++i) yw[i] = xr[i];
#pragma unroll
                for (int q = 0; q < 8; ++q) { const unsigned w0 = yw[q >> 1][2 * (q & 1)], w1 = yw[q >> 1][2 * (q & 1) + 1]; const f32x4 gq = LNV(0, q), bq = LNV(1, q);
                    xf2[2 * q] = f32x2_t{rstd * bf_lo(w0) + (bq.x - mr * gq.x), rstd * bf_hi(w0) + (bq.y - mr * gq.y)}; xf2[2 * q + 1] = f32x2_t{rstd * bf_lo(w1) + (bq.z - mr * gq.z), rstd * bf_hi(w1) + (bq.w - mr * gq.w)}; }
#if U_I4
                {
                    float mx = 0.f;
#pragma unroll
                    for (int i = 0; i < 16; ++i) mx = fmaxf(mx, fmaxf(fabsf(xf2[i].x), fabsf(xf2[i].y)));
                    mx = wave_max_all(mx);
                    const float isx = mx > 1e-30f ? 119.f / mx : 0.f; xscale = mx * (1.f / 119.f);
#pragma unroll
                    for (int d = 0; d < 4; ++d) { unsigned h_ = 0u, l_ = 0u;
#pragma unroll
                        for (int j = 0; j < 8; ++j) { const int el = 8 * d + j; const float xv = (el & 1) ? xf2[el >> 1].y : xf2[el >> 1].x; const int qi = (int)__builtin_bit_cast(unsigned, __builtin_fmaf(xv, isx, 12582912.f)) - 0x4B400000; const int hi = (qi + 8) >> 4, lo = qi - (hi << 4);
                            h_ |= ((unsigned)hi & 15u) << (4 * j); l_ |= ((unsigned)lo & 15u) << (4 * j); }
                        xh[d] = (int)h_; xl[d] = (int)l_; }
                }
#endif
            }
#if U_FP4
            v4u uid[4];
            { const LAS v4u* ip = (const LAS v4u*)(Ebuf + (base + 16 < 512 ? base + 16 : 496));
#pragma unroll
              for (int i = 0; i < 4; ++i) uid[i] = ip[i]; }
#endif
            float part[16];
#pragma unroll
            for (int k = 0; k < 16; ++k) {
                f32x2_t A0 = {0.f, 0.f}, A1 = {0.f, 0.f};
#if U_I4
                { const v4u pk = ub[k % PFU]; int aH = 0, aL = 0;
#pragma unroll
                  for (int d4 = 0; d4 < 4; ++d4) { aH = __builtin_amdgcn_sdot8((int)pk[d4], xh[d4], aH, false); aL = __builtin_amdgcn_sdot8((int)pk[d4], xl[d4], aL, false); }
                  part[k] = (float)(aH * 16 + aL) * usc[k % PFU]; (void)A0; (void)A1; }
                { const unsigned e_ = uid[k >> 2][k & 3]; ub[k % PFU] = *(const GAS v4u*)(ut + ((e_ << 10) + lane16)); usc[k % PFU] = *(const GAS float*)((const unsigned char*)us + (e_ << 2)); }
#elif U_FP4
                { const v4u pk = ub[k % PFU]; const float sc_ = usc[k % PFU];
#pragma unroll
                  for (int d4 = 0; d4 < 4; ++d4) { const f32x2_t p0 = __builtin_amdgcn_cvt_scalef32_pk_f32_fp4(pk[d4], sc_, 0), p1 = __builtin_amdgcn_cvt_scalef32_pk_f32_fp4(pk[d4], sc_, 1), p2 = __builtin_amdgcn_cvt_scalef32_pk_f32_fp4(pk[d4], sc_, 2), p3 = __builtin_amdgcn_cvt_scalef32_pk_f32_fp4(pk[d4], sc_, 3);
                      A0 = __builtin_elementwise_fma(p0, xf2[4 * d4], A0); A1 = __builtin_elementwise_fma(p1, xf2[4 * d4 + 1], A1); A0 = __builtin_elementwise_fma(p2, xf2[4 * d4 + 2], A0); A1 = __builtin_elementwise_fma(p3, xf2[4 * d4 + 3], A1); } }
                part[k] = (A0.x + A0.y) + (A1.x + A1.y);
                { const unsigned e_ = (PFU == 16) ? uid[k >> 2][k & 3] : Ebuf[(base + k + PFU) < 512 ? (base + k + PFU) : 511]; ub[k % PFU] = *(const GAS v4u*)(ut + ((e_ << 10) + lane16)); usc[k % PFU] = *(const GAS float*)((const unsigned char*)us + (e_ << 2)); }
#else
                v6u pk; pk[0] = ub[k % PFU][0][0]; pk[1] = ub[k % PFU][0][1]; pk[2] = ub[k % PFU][0][2]; pk[3] = ub[k % PFU][1][0]; pk[4] = ub[k % PFU][1][1]; pk[5] = ub[k % PFU][1][2];
                const f32x32 dv = __builtin_amdgcn_cvt_scalef32_pk32_f32_fp6(pk, usc[k % PFU]);
#pragma unroll
                for (int q = 0; q < 8; ++q) { A0 = __builtin_elementwise_fma(f32x2_t{dv[4 * q], dv[4 * q + 1]}, xf2[2 * q], A0); A1 = __builtin_elementwise_fma(f32x2_t{dv[4 * q + 2], dv[4 * q + 3]}, xf2[2 * q + 1], A1); }
                part[k] = (A0.x + A0.y) + (A1.x + A1.y);
                { int nx = base + k + PFU; nx = nx < 512 ? nx : 511; const unsigned e_ = Ebuf[nx]; const unsigned char* p = ut + (size_t)e_ * 1536 + 24 * lane; ub[k % PFU][0] = *(const GAS v3u*)p; ub[k % PFU][1] = *(const GAS v3u*)(p + 12); usc[k % PFU] = us[e_]; }
#endif
            }
#pragma unroll
            for (int i = 0; i < 8; ++i) part[i] = swapsum32(part[i], part[i + 8]);
#pragma unroll
            for (int i = 0; i < 4; ++i) part[i] = swapsum16(part[i], part[i + 4]);
#pragma unroll
            for (int i = 0; i < 2; ++i) { const bool up = lane & 8; const float snd = up ? part[i] : part[i + 2], kp = up ? part[i + 2] : part[i]; part[i] = kp + xor8f(snd); }
            { const bool up = lane & 4; const float snd = up ? part[0] : part[1], kp = up ? part[1] : part[0]; part[0] = kp + xor4f(snd); }
            part[0] += xor2f(part[0]); part[0] += xor1f(part[0]);
#if U_I4
            part[0] *= xscale;
#endif
            if ((lane & 3) == 0) Hbuf[base + kl] = Gbuf[base + kl] * gelu_erf(part[0]) * hscale;
        }
    }
#endif
    LDS_WAIT();
    if (nstages < 3) return;
    {
#if V_FP4
        v4u vb[PFV]; float vsc[PFV];
#pragma unroll
        for (int j = 0; j < PFV; ++j) { const unsigned e_ = Ebuf[j]; vb[j] = *(const GAS v4u*)(vt + (size_t)e_ * 1024 + 16 * lane); vsc[j] = (U_I4 && U_CHUNKED) ? Gbuf[j] : vs[e_]; }
#else
        v3u vb[PFV][2]; float vsc[PFV];
#pragma unroll
        for (int j = 0; j < PFV; ++j) { const unsigned e_ = Ebuf[j]; const unsigned char* p = vt + (size_t)e_ * 1536 + 24 * lane; vb[j][0] = *(const GAS v3u*)p; vb[j][1] = *(const GAS v3u*)(p + 12); vsc[j] = vs[e_]; }
#endif
        f32x2_t acc2[16];
#define acc_(i) acc2[(i) >> 1][(i) & 1]
#pragma unroll
        for (int q = 0; q < 16; ++q) acc2[q] = f32x2_t{0.f, 0.f};
        v4u yv[4]; long long sv[2];
#pragma unroll 1
        for (int base = 0; base < 512; base += PFV) {
            if ((base & 127) == 128 - 3 * PFV) { const size_t tk = (size_t)(tok0 + (base >> 7)); const GAS v4u* xr = (const GAS v4u*)(x1f + tk * D + 32 * lane);
#pragma unroll
                for (int q = 0; q < 4; ++q) yv[q] = xr[q];
                sv[0] = stat1[2 * tk]; sv[1] = stat1[2 * tk + 1]; }
#if V_FP4
            v4u vid[4]; f32x4 vsn[4];
            { const LAS v4u* ip = (const LAS v4u*)(Ebuf + (base + 16 < 512 ? base + 16 : 496)); const LAS f32x4* sp_ = (const LAS f32x4*)(Gbuf + (base + 16 < 512 ? base + 16 : 496));
#pragma unroll
              for (int i = 0; i < 4; ++i) { vid[i] = ip[i]; vsn[i] = sp_[i]; } }
#endif
            f32x4 hv[PFV / 4];
            { const LAS f32x4* hp = (const LAS f32x4*)(Hbuf + base);
#pragma unroll
              for (int i = 0; i < PFV / 4; ++i) hv[i] = hp[i]; }
#pragma unroll
            for (int k = 0; k < PFV; ++k) {
                const float hk = hv[k >> 2][k & 3]; const f32x2_t hk2 = {hk, hk};
#if V_FP4
                { const v4u pk = vb[k]; const float sc_ = vsc[k];
#pragma unroll
                  for (int d4 = 0; d4 < 4; ++d4) { const f32x2_t p0 = __builtin_amdgcn_cvt_scalef32_pk_f32_fp4(pk[d4], sc_, 0), p1 = __builtin_amdgcn_cvt_scalef32_pk_f32_fp4(pk[d4], sc_, 1), p2 = __builtin_amdgcn_cvt_scalef32_pk_f32_fp4(pk[d4], sc_, 2), p3 = __builtin_amdgcn_cvt_scalef32_pk_f32_fp4(pk[d4], sc_, 3);
                      acc2[4 * d4] = __builtin_elementwise_fma(hk2, p0, acc2[4 * d4]); acc2[4 * d4 + 1] = __builtin_elementwise_fma(hk2, p1, acc2[4 * d4 + 1]); acc2[4 * d4 + 2] = __builtin_elementwise_fma(hk2, p2, acc2[4 * d4 + 2]); acc2[4 * d4 + 3] = __builtin_elementwise_fma(hk2, p3, acc2[4 * d4 + 3]); } }
                { const unsigned e_ = (PFV == 16) ? vid[k >> 2][k & 3] : Ebuf[(base + k + PFV) < 512 ? (base + k + PFV) : 511]; vb[k] = *(const GAS v4u*)(vt + ((e_ << 10) + lane16)); vsc[k] = (U_I4 && U_CHUNKED) ? vsn[k >> 2][k & 3] : *(const GAS float*)((const unsigned char*)vs + (e_ << 2)); }
#else
                v6u pk; pk[0] = vb[k][0][0]; pk[1] = vb[k][0][1]; pk[2] = vb[k][0][2]; pk[3] = vb[k][1][0]; pk[4] = vb[k][1][1]; pk[5] = vb[k][1][2];
                const f32x32 dv = __builtin_amdgcn_cvt_scalef32_pk32_f32_fp6(pk, vsc[k]);
#pragma unroll
                for (int q = 0; q < 16; ++q) acc2[q] = __builtin_elementwise_fma(hk2, f32x2_t{dv[2 * q], dv[2 * q + 1]}, acc2[q]);
                { int nx = base + k + PFV; nx = nx < 512 ? nx : 511; const unsigned e_ = Ebuf[nx]; const unsigned char* p = vt + (size_t)e_ * 1536 + 24 * lane; vb[k][0] = *(const GAS v3u*)p; vb[k][1] = *(const GAS v3u*)(p + 12); vsc[k] = vs[e_]; }
#endif
            }
            if ((base & 127) == 128 - PFV) {
                const size_t tok = (size_t)(tok0 + (base >> 7));
                { const float s1_ = (float)sv[0] * 2.3283064365386963e-10f, s2_ = (float)sv[1] * 2.3283064365386963e-10f; const float mu_ = s1_ * (1.f / D), rs_ = 1.f / sqrtf(s2_ * (1.f / D) - mu_ * mu_ + LN_EPS), mr_ = mu_ * rs_;
#pragma unroll
                  for (int q = 0; q < 8; ++q) { const unsigned w0 = yv[q >> 1][2 * (q & 1)], w1 = yv[q >> 1][2 * (q & 1) + 1]; const f32x4 gq = LNV(0, q), bq = LNV(1, q);
                      acc_(4 * q) += ALPHA * (rs_ * bf_lo(w0) + (bq.x - mr_ * gq.x)); acc_(4 * q + 1) += ALPHA * (rs_ * bf_hi(w0) + (bq.y - mr_ * gq.y)); acc_(4 * q + 2) += ALPHA * (rs_ * bf_lo(w1) + (bq.z - mr_ * gq.z)); acc_(4 * q + 3) += ALPHA * (rs_ * bf_hi(w1) + (bq.w - mr_ * gq.w)); } }
                float s = 0.f;
#pragma unroll
                for (int q = 0; q < 32; ++q) s += acc_(q);
                const float mean = wave_sum(s) * (1.f / D); float s2 = 0.f;
#pragma unroll
                for (int q = 0; q < 32; ++q) { acc_(q) -= mean; s2 += acc_(q) * acc_(q); }
                const float rstd = 1.f / sqrtf(wave_sum(s2) * (1.f / D) + LN_EPS);
                const int col = 32 * lane;
#pragma unroll
                for (int q = 0; q < 8; q += 2) { v4u wb;
#pragma unroll
                    for (int h2 = 0; h2 < 2; ++h2) { const int qq = q + h2; const f32x4 gq = LNV(2, qq), bq = LNV(3, qq);
                        f32x4 o; o.x = acc_(4 * qq) * rstd * gq.x + bq.x; o.y = acc_(4 * qq + 1) * rstd * gq.y + bq.y; o.z = acc_(4 * qq + 2) * rstd * gq.z + bq.z; o.w = acc_(4 * qq + 3) * rstd * gq.w + bq.w;
                        if (xf_out) *(GAS f32x4*)(xf_out + tok * D + col + 4 * qq) = o; wb[2 * h2] = pkbf(o.x, o.y); wb[2 * h2 + 1] = pkbf(o.z, o.w); }
                    if (xb_out) *(GAS v4u*)(xb_out + tok * D + col + 4 * q) = wb; }
#pragma unroll
                for (int q = 0; q < 32; ++q) acc_(q) = 0.f;
            }
        }
#undef acc_
    }
}

#ifndef EN_MASK
#define EN_MASK 0x1ff
#endif
constexpr bool EN_P0 = EN_MASK & 1, EN_P1 = EN_MASK & 2, EN_QKV = EN_MASK & 4, EN_SWA = EN_MASK & 8, EN_DA = EN_MASK & 16, EN_WO = EN_MASK & 32, EN_LN = EN_MASK & 64, EN_SC = EN_MASK & 128, EN_PEER = EN_MASK & 256;

struct Args { const float* in[19]; float* out; unsigned char* ws; int ph_lo, ph_hi, li, pad; };
__global__ void __launch_bounds__(NWAVES * 64, 2) hybrid_fwd(Args args) {
    extern __shared__ __attribute__((aligned(16))) unsigned char lds[];
    Frame F;
    F.lds = (LAS unsigned char*)lds;
    F.wave = __builtin_amdgcn_readfirstlane((int)(threadIdx.x >> 6));
    F.G = gridDim.x; { const int bx = blockIdx.x; F.vcu = (F.G % 8 == 0) ? (bx % 8) * (F.G / 8) + bx / 8 : bx; }
    for (int u = threadIdx.x; u < (LDS_BYTES - LDSCTL_OFF) / 4; u += NWAVES * 64) ((LAS unsigned*)(F.lds + LDSCTL_OFF))[u] = 0u;
    __syncthreads();
    if (threadIdx.x < 19) *(LAS unsigned long long*)(F.lds + PT_OFF + 8 * threadIdx.x) = (unsigned long long)args.in[threadIdx.x];
    if (threadIdx.x == 19) *(LAS unsigned long long*)(F.lds + PT_OFF + 8 * PT_OUT) = (unsigned long long)args.out;
    if (threadIdx.x == 20) *(LAS unsigned long long*)(F.lds + PT_OFF + 8 * PT_WS) = (unsigned long long)args.ws;
    __syncthreads();
    XcdBarrier bar = xcd_barrier_post((unsigned*)(args.ws + WS_CTL) + CW_BAR + args.li * XCD_BAR_WORDS, (volatile LAS unsigned*)(F.lds + MISC_OFF) + 8);
    const int lo = args.ph_lo, hi = args.ph_hi;
#define IN(k) (lo <= (k) && (k) < hi)
#define SEAM(k) do { if ((k) + 1 < hi) xcd_barrier(bar); } while (0)
#define RPT(bit, ...) do { __VA_ARGS__; if (RPT_MASK & (bit)) { xcd_barrier(bar); __VA_ARGS__; } } while (0)

    if (EN_P0 && IN(0)) { RPT(1, p0_prologue(F)); SEAM(0); }
    if ((PROBE_MASK & 8) && IN(1)) { p1_simple(F); SEAM(1); }
    else if (EN_P1 && IN(1)) {
        unsigned char* ws = ldws(F);
        pg8::Gemm g{(const pg8::bf16_t*)(ws + WS_ABLK), (const pg8::bf16_t*)(ws + WS_WQB), DEPTH * 2048, 2048, 2048, 1};
        pg8::StackOrder S; S.init(DEPTH * 2048, 2048, F.G, (int)blockIdx.x);
        pg8::EpiBf16S E{(pg8::bf16_t*)(ws + WS_WEFF), 2048, 0, 1.f, 7};
        RPT(2, pg8::gemm_phase<pg8::EpiBf16S, pg8::StackOrder, true, true>(F.lds + RING_OFF, g, S, E, F.wave));
    }
    const Frame F0 = F; const int lo0 = lo, hi0 = hi;
#pragma unroll 1
    for (int L = 0; L < DEPTH; ++L) {
        Frame F; F.wave = opaque_u(F0.wave); F.vcu = opaque_u(F0.vcu); F.G = opaque_u(F0.G); F.lds = (LAS unsigned char*)(size_t)(unsigned)opaque_u((int)(unsigned)(size_t)F0.lds);
        const int lo = opaque_u(lo0), hi = opaque_u(hi0);
        const int pb = 2 + 6 * L, j = L >> 1; const bool isB = L & 1;
        if (EN_QKV && IN(pb + 0)) {
            unsigned char* ws = ldws(F);
            const int N = isB ? B_QKV : A_QKV;
            const pg8::bf16_t* Wt = isB ? (const pg8::bf16_t*)(ws + WS_WQKVB) + (size_t)j * B_QKV * D : (const pg8::bf16_t*)(ws + WS_WQKVA) + (size_t)j * A_QKV * D;
            pg8::Gemm g{(const pg8::bf16_t*)(ws + WS_XB), Wt, T, N, D, 0};
            pg8::StaticOrder S; S.init(T, N, F.G, (int)blockIdx.x);
            pg8::EpiBf16S E{(pg8::bf16_t*)(ws + WS_QKV), N, 2048, C2, 0x7fffffff};
            RPT(2, pg8::gemm_phase<pg8::EpiBf16S, pg8::StaticOrder, true, true>(F.lds + RING_OFF, g, S, E, F.wave));
            if (TABLE_FILL && !isB) peer_tables_fill(F, L + 1, (unsigned*)(ws + WS_CTL) + CW_CVT + 64 * j);
            SEAM(pb + 0);
        }
        if (IN(pb + 1)) {
            unsigned char* ws = ldws(F);
            if (EN_SWA && !isB) {
                if (L == 0) p1b_vectors(F);
                const float* sinks = ldin(F, 2) + j * 32;
                RPT(4, for (int u = F.vcu; u < 256; u += F.G) swa_unit(F, (const bf16*)(ws + WS_QKV), (bf16*)(ws + WS_OB), sinks, u >> 2, u & 3));
            } else if (EN_DA && isB) {
                const float li = (L == 1) ? 0.35550906759096926f : 0.5560582041556405f;
                const int ln = lane_id();
                float d1 = ldin(F, 5)[j * 64 + ln] * ldin(F, 6)[j * 64 + ln], d2 = ldin(F, 7)[j * 64 + ln] * ldin(F, 8)[j * 64 + ln];
                d1 = wave_sum(d1); d2 = wave_sum(d2);
                const float lam = expf(d1) - expf(d2) + li;
                float* stash = (float*)(ws + WS_STASH) + (size_t)blockIdx.x * (256 * 128);
                const float* subg = ldin(F, 9) + j * 128;
                unsigned* bnd = (unsigned*)(ws + WS_CTL) + CW_DA + 64 * j;
                da_norms(F, (const bf16*)(ws + WS_QKV), bnd);
                xcd_barrier(bar);
                LAS unsigned* TBL = (LAS unsigned*)(F.lds + RING_OFF + 100 * 1024);
                LAS unsigned* TB2 = TBL + 1024;
                LAS unsigned* SPL = TBL + 2048;
                LAS unsigned* HST = TBL + 2048 + 192;
                for (int i = threadIdx.x; i < 129; i += NWAVES * 64) HST[i] = 0u;
                __syncthreads();
                if (F.wave == 0) {
                    const int ln = lane_id();
                    unsigned ka[8], km[8], kb[8]; int spl[8]; int nspl_l = 0;
#pragma unroll
                    for (int q = 0; q < 8; ++q) { const int idx = 8 * ln + q, qb = 31 - (idx >> 4), h = 15 - (idx & 15);
                        const float qn2 = __builtin_bit_cast(float, __hip_atomic_load(bnd + h, __ATOMIC_RELAXED, __HIP_MEMORY_SCOPE_AGENT)), kn2 = __builtin_bit_cast(float, __hip_atomic_load(bnd + 16 + h, __ATOMIC_RELAXED, __HIP_MEMORY_SCOPE_AGENT));
                        const float B = sqrtf(qn2 * kn2) * 1.001f, slope2 = exp2f(-0.5f * (float)(h + 1)) * LOG2E, dsk = (160.f + 2.f * B) / slope2;
                        int kt_lo = 0; if (dsk < 16384.f) { const int first = 256 * qb - ((int)dsk + 2); kt_lo = first > 0 ? (first >> 6) : 0; }
                        const int khi = 4 * qb + 4, cost = khi - kt_lo;
                        ka[q] = (unsigned)kt_lo; kb[q] = (unsigned)khi; km[q] = (unsigned)(kt_lo + (cost >> 1)); spl[q] = cost > DA_CMAX ? 1 : 0; nspl_l += spl[q]; }
                    int ospl = nspl_l;
#pragma unroll
                    for (int o = 1; o < 64; o <<= 1) { const int b = __shfl_up(ospl, o); if (ln >= o) ospl += b; }
                    const int tot_spl = __shfl(ospl, 63);
                    int pp = ospl - nspl_l;
#pragma unroll
                    for (int q = 0; q < 8; ++q) { if (spl[q]) { if (pp >= 128) spl[q] = 0; ++pp; } }
                    pp = ospl - nspl_l;
#pragma unroll
                    for (int q = 0; q < 8; ++q) { if (spl[q]) { __hip_atomic_fetch_add(HST + (kb[q] - km[q]), 1u, __ATOMIC_RELAXED, __HIP_MEMORY_SCOPE_WORKGROUP); __hip_atomic_fetch_add(HST + (km[q] - ka[q]), 1u, __ATOMIC_RELAXED, __HIP_MEMORY_SCOPE_WORKGROUP); } else __hip_atomic_fetch_add(HST + (kb[q] - ka[q]), 1u, __ATOMIC_RELAXED, __HIP_MEMORY_SCOPE_WORKGROUP); }
                    LDS_WAIT();
                    { const unsigned c_hi = HST[128 - 2 * ln], c_lo = HST[127 - 2 * ln]; unsigned run = c_hi + c_lo;
#pragma unroll
                      for (int o = 1; o < 64; o <<= 1) { const unsigned b = __shfl_up(run, o); if (ln >= o) run += b; }
                      const unsigned ex = run - (c_hi + c_lo); LDS_WAIT(); HST[128 - 2 * ln] = ex; HST[127 - 2 * ln] = ex + c_hi; if (ln == 63) SPL[128] = run; }
                    LDS_WAIT();
#pragma unroll
                    for (int q = 0; q < 8; ++q) { const unsigned idx = (unsigned)(8 * ln + q);
                        if (spl[q]) { const unsigned p1 = __hip_atomic_fetch_add(HST + (kb[q] - km[q]), 1u, __ATOMIC_RELAXED, __HIP_MEMORY_SCOPE_WORKGROUP), p2 = __hip_atomic_fetch_add(HST + (km[q] - ka[q]), 1u, __ATOMIC_RELAXED, __HIP_MEMORY_SCOPE_WORKGROUP);
                            TBL[p1] = idx | (1u << 9) | (km[q] << 11) | (kb[q] << 19); TB2[p1] = (unsigned)pp; TBL[p2] = idx | (2u << 9) | (ka[q] << 11) | (km[q] << 19); TB2[p2] = (unsigned)pp; SPL[pp] = idx; ++pp; }
                        else { const unsigned p1 = __hip_atomic_fetch_add(HST + (kb[q] - ka[q]), 1u, __ATOMIC_RELAXED, __HIP_MEMORY_SCOPE_WORKGROUP); TBL[p1] = idx | (ka[q] << 11) | (kb[q] << 19); TB2[p1] = 0u; } }
                    LDS_WAIT();
                    if (ln == 63) { SPL[129] = (unsigned)(tot_spl < 128 ? tot_spl : 128); }
                }
                __syncthreads();
                __syncthreads();
                float* PO = (float*)(ws + WS_YF); float* PS = (float*)(ws + WS_SC);
#pragma unroll 1
                for (int rep = 0; rep < ((RPT_MASK & 8) ? 2 : 1); ++rep) {
                if (rep) xcd_barrier(bar);
                const unsigned nsub = SPL[128];
                for (;;) {
                    volatile LAS unsigned* slot = (volatile LAS unsigned*)(F.lds + MISC_OFF) + 16;
                    __syncthreads();
                    if (threadIdx.x == 0) *slot = atomicAdd(bnd + 32 + rep, 1u);
                    __syncthreads();
                    const unsigned u = *slot;
                    if (u >= nsub) break;
                    const unsigned e = TBL[u], ss_ = TB2[u];
                    if (e == 0xFFFFFFFFu) continue;
                    const int idx = (int)(e & 511u), part = (int)((e >> 9) & 3u), kta = (int)((e >> 11) & 255u), ktb = (int)((e >> 19) & 255u);
                    const int qb = 31 - (idx >> 4), h = 15 - (idx & 15);
                    const size_t pslot = (size_t)ss_ * 2 + (part == 2 ? 1 : 0);
                    dattn_unit(F, (const bf16*)(ws + WS_QKV), (bf16*)(ws + WS_OB), stash, subg, lam, 1.f - li, h, qb, kta, ktb, part, PO + pslot * 65536, PS + pslot * 2048);
                }
                xcd_barrier(bar);
                const unsigned nspl = SPL[129];
                for (;;) {
                    volatile LAS unsigned* slot = (volatile LAS unsigned*)(F.lds + MISC_OFF) + 16;
                    __syncthreads();
                    if (threadIdx.x == 0) *slot = atomicAdd(bnd + 36 + rep, 1u);
                    __syncthreads();
                    const unsigned s = *slot;
                    if (s >= nspl) break;
                    const int idx = (int)SPL[s], qb = 31 - (idx >> 4), h = 15 - (idx & 15);
                    da_combine(F, (bf16*)(ws + WS_OB), PO + (size_t)s * 131072, PS + (size_t)s * 4096, subg, lam, 1.f - li, h, qb);
                }
                }
            }
            SEAM(pb + 1);
        }
        if (EN_WO && IN(pb + 2)) {
            unsigned char* ws = ldws(F);
            pg8::Gemm g{(const pg8::bf16_t*)(ws + WS_OB), (const pg8::bf16_t*)(ws + WS_WO) + (size_t)L * D * D, T, D, D, 0};
            pg8::StaticOrder S; S.init(T, D, F.G, (int)blockIdx.x);
            pg8::EpiResLnStat E{(const pg8::bf16_t*)(ws + WS_XB), (float*)nullptr, (pg8::bf16_t*)(ws + WS_XF), ldin(F, 11) + L * D, (unsigned long long*)(ws + WS_STAT) + (size_t)L * T * 2, D, ALPHA, ((PROBE_MASK & (isB ? 2 : 1)) ? 0.f : 1.f)};
            pg8::gemm_phase<pg8::EpiResLnStat, pg8::StaticOrder, true, true>(F.lds + RING_OFF, g, S, E, F.wave);
            SEAM(pb + 2);
        }
        if (false && EN_LN && IN(pb + 3)) {
 unsigned char* ws = ldws(F); RPT(16, ln_phase(F, (const float*)(ws + WS_YF), ldin(F, 11) + L * D, ldin(F, 12) + L * D, (float*)(ws + WS_XF), (bf16*)(ws + WS_XB))); SEAM(pb + 3); }
        if (EN_SC && IN(pb + 4)) {
            unsigned char* ws = ldws(F);
            pg8::Gemm g{(const pg8::bf16_t*)(ws + WS_XF), (const pg8::bf16_t*)(ws + WS_WEFF) + (size_t)L * 2048 * D, T, 2048, D, 0};
            pg8::StaticOrder S; S.init(T, 2048, F.G, (int)blockIdx.x);
            pg8::EpiScLn E{(_Float16*)(ws + WS_SC), 2048, (const long long*)(ws + WS_STAT) + (size_t)L * T * 2, (const float*)(ws + WS_CSW) + L * 2048, (const float*)(ws + WS_CSW) + DEPTH * 2048 + L * 2048, 1.f / D, LN_EPS};
            RPT(2, pg8::gemm_phase<pg8::EpiScLn, pg8::StaticOrder, true, true>(F.lds + RING_OFF, g, S, E, F.wave));
            SEAM(pb + 4);
        }
        if (EN_PEER && IN(pb + 5)) {
            unsigned char* ws = ldws(F);
            const int gw = F.vcu * NWAVES + F.wave, NGW = F.G * NWAVES;
            LAS unsigned char* wl = F.lds + RING_OFF + F.wave * PEER_WAVE_LDS;
            const bool last = (L == DEPTH - 1);
            {
                __syncthreads();
                for (int i = threadIdx.x; i < 4 * 512; i += NWAVES * 64) { const int v = i >> 9, e = i & 511; const float* srcv = (v == 0 ? ldin(F, 11) : v == 1 ? ldin(F, 12) : v == 2 ? ldin(F, 13) : ldin(F, 14)) + L * D;
                    *(LAS f32x4*)(F.lds + RING_OFF + PEER_LNV_OFF + v * 8192 + (e & 7) * 1024 + (e >> 3) * 16) = *(const GAS f32x4*)(srcv + 4 * e); }
                __syncthreads();
            }
            float* xf_out = last ? (float*)ldp_raw(F, PT_OUT) : (float*)nullptr;
#pragma unroll 1
            for (int rep = ((RPT_MASK & 32) ? 0 : 1); rep < 2; ++rep) {
            if (rep == 1 && (RPT_MASK & 32)) xcd_barrier(bar);
            float* xfo = rep ? xf_out : (float*)(ws + WS_QKV); bf16* xbo = (rep && !last) ? (bf16*)(ws + WS_XB) : (bf16*)nullptr;
            for (int grp = gw; grp < T / 4; grp += NGW)
                peer_group(F, wl, 4 * grp, (const _Float16*)(ws + WS_SC), (const bf16*)(ws + WS_XF), (const long long*)(ws + WS_STAT) + (size_t)L * T * 2, ldin(F, 11) + L * D, ldin(F, 12) + L * D, ws + WS_UT + (size_t)L * NE * (U_FP4 ? 1024 : 1536), ws + WS_VT + (size_t)L * NE * (V_FP4 ? 1024 : 1536), (const float*)(ws + WS_US) + L * NE, (const float*)(ws + WS_VS) + L * NE,
                           ldin(F, 13) + L * D, ldin(F, 14) + L * D, xfo, xbo, (float)((PEER_HS >> (4 * L)) & 15) * 0.5f - 1.f, (((PROBE_MASK & 64) && (L == DIAG_LAYER)) || (PROBE_MASK & 128)) ? (unsigned*)(ws + WS_STASH) : (unsigned*)nullptr, ldin(F, 17) + (size_t)L * NE * D, rep ? 3 : PEER_DRY);
            }
            SEAM(pb + 5);
        }
    }
#if (STOP_AFTER >= 0)
    if (IN(N_PHASES)) {
        unsigned char* ws = ldws(F); const f32x4* src = (const f32x4*)(ws + (COPY_SRC == 0 ? WS_XF : (COPY_SRC == 1 ? WS_YF : WS_SC))); f32x4* dst = (f32x4*)ldp_raw(F, PT_OUT);
        for (size_t i = (size_t)blockIdx.x * 512 + threadIdx.x; i < (size_t)T * D / 4; i += (size_t)gridDim.x * 512) dst[i] = src[i]; }
#endif
#if (PROBE_MASK & 64)
    if (IN(N_PHASES)) { if (blockIdx.x == 0 && threadIdx.x == 0) { const unsigned* dg = (const unsigned*)(ldws(F) + WS_CTL) + 2048;
        auto bucket = [](unsigned c) { unsigned b = 0; while (c) { ++b; c >>= 1; } return b > 8u ? 8u : b; };
        const unsigned a = bucket(__hip_atomic_load(dg + DIAG_A, __ATOMIC_RELAXED, __HIP_MEMORY_SCOPE_AGENT)), b = bucket(__hip_atomic_load(dg + DIAG_B, __ATOMIC_RELAXED, __HIP_MEMORY_SCOPE_AGENT));
        ((float*)ldp_raw(F, PT_OUT))[0] = 100.f * (float)((a + 1) * 10 + b); } }
#endif
#undef IN
#undef SEAM
}

#ifndef MK_PER_PHASE
#define MK_PER_PHASE 0
#endif
extern "C" void kernel_launch(void* const* d_in, const int* in_sizes, int n_in, void* d_out, int out_size, void* d_ws, size_t ws_size, hipStream_t stream) {
    static int grid = 0;
    if (grid == 0) {
        if (n_in != 19 || in_sizes[0] != T * D || out_size != T * D || ws_size < WS_END) { fprintf(stderr, "kernel_launch: unexpected shapes (n_in %d, in0 %d, out %d, ws %zu < %zu); nothing launched\n", n_in, n_in > 0 ? in_sizes[0] : -1, out_size, ws_size, (size_t)WS_END); grid = -1; return; }
        int dev = 0, cus = 0, per_cu = 0;
        if (hipGetDevice(&dev) != hipSuccess || hipDeviceGetAttribute(&cus, hipDeviceAttributeMultiprocessorCount, dev) != hipSuccess) { fprintf(stderr, "kernel_launch: device query failed\n"); grid = -1; return; }
        if (hipFuncSetAttribute((const void*)hybrid_fwd, hipFuncAttributeMaxDynamicSharedMemorySize, LDS_BYTES) != hipSuccess) { fprintf(stderr, "kernel_launch: hipFuncSetAttribute failed\n"); grid = -1; return; }
        if (hipOccupancyMaxActiveBlocksPerMultiprocessor(&per_cu, (const void*)hybrid_fwd, NWAVES * 64, LDS_BYTES) != hipSuccess || per_cu < 1)
            fprintf(stderr, "kernel_launch: note: occupancy query reports %d workgroups per CU\n", per_cu);
        (void)hipGetLastError();
        grid = cus;
    }
    if (grid < 0) return;
    if (hipMemsetAsync((char*)d_ws + WS_CTL, 0, CTL_ZERO_BYTES, stream) != hipSuccess) { fprintf(stderr, "kernel_launch: memset failed\n"); return; }
    Args a{};
    for (int i = 0; i < 19; ++i) a.in[i] = (const float*)d_in[i];
    a.out = (float*)d_out; a.ws = (unsigned char*)d_ws; a.pad = 0;
#if MK_PER_PHASE
    for (int p = 0; p < N_PHASES + (((PROBE_MASK & 64) || STOP_AFTER >= 0) ? 1 : 0); ++p) { if (STOP_AFTER >= 0 && p > STOP_AFTER && p < N_PHASES) continue; a.ph_lo = p; a.ph_hi = p + 1; a.li = 0;
        hipLaunchKernelGGL(hybrid_fwd, dim3(grid), dim3(NWAVES * 64), LDS_BYTES, stream, a);
        if (hipPeekAtLastError() != hipSuccess) { fprintf(stderr, "kernel_launch: launch of phase %d failed\n", p); break; }
#if (PROBE_MASK & 64)
        if (p == 2 + 6 * DIAG_LAYER + 5) hipLaunchKernelGGL(peer_cmp_kernel, dim3(32), dim3(64), 0, stream, (const unsigned char*)d_ws);
        if (p == 2 + 6 * DIAG_LAYER + 4) hipLaunchKernelGGL(peer_ref_kernel, dim3(32), dim3(64), 0, stream, (const unsigned char*)d_ws, (const float*)d_in[17], (size_t)DIAG_LAYER * NE * D, (size_t)(WS_CTL + 4 * (2048 + 16384)), 256, 32);
#endif
    }
#else
    a.ph_lo = 0; a.ph_hi = N_PHASES; a.li = 0;
    hipLaunchKernelGGL(hybrid_fwd, dim3(grid), dim3(NWAVES * 64), LDS_BYTES, stream, a);
    if (hipPeekAtLastError() != hipSuccess) fprintf(stderr, "kernel_launch: launch failed\n");
#endif
}
```

```cpp
#include <hip/hip_runtime.h>
#include <cstdio>
#include <cstdint>
#include <cmath>
namespace pg8 {
#define PG8_LAS __attribute__((address_space(3)))
typedef unsigned short bf16_t;
typedef short bf16x8 __attribute__((ext_vector_type(8)));
typedef float f32x4 __attribute__((ext_vector_type(4)));
typedef unsigned u32x4 __attribute__((ext_vector_type(4)));
constexpr int BM = 256, BK = 64, HALF = 128, HTB = HALF * BK * 2  , STAGE_BYTES = 8 * HTB, NXCD = 8, WGM = 8;

__host__ __device__ __forceinline__ int lds_byte(int r, int c) { const int st = (r >> 4) * 2 + (c >> 5), rr = r & 15, cc = c & 31, ob = rr * 64 + cc * 2; return st * 1024 + (ob ^ (((ob >> 9) & 1) << 5)); }
__host__ __device__ __forceinline__ void stage_rc(int b, int& R, int& C) { const int st = b / 1024, sb = b % 1024, swz = sb ^ (((sb >> 9) & 1) << 5); R = (st >> 1) * 16 + swz / 64; C = (st & 1) * 32 + (swz % 64) / 2; }
__host__ __device__ __forceinline__ int perm32(int rho) { const int n = rho >> 4, i = rho & 15; return 8 * (i >> 2) + 4 * n + (i & 3); }

struct Unit { int pm, pn; };
struct Gemm { const bf16_t* A; const bf16_t* Bt; int M, N, K; int kdiag; };

struct StaticOrder {
    int nM, nN, nwg, G, c;
    __host__ __device__ void init(int M, int N, int G_, int c_) { nM = M / BM; nN = N / BM; nwg = nM * nN; G = G_; c = c_; }
    __host__ __device__ bool next(int i, Unit& u) const {
        const long L = (long)i * G + c; if (L >= nwg) return false;
        int wgid = (int)L; { const int q = nwg / NXCD, r = nwg % NXCD, xcd = wgid % NXCD, off = wgid / NXCD; wgid = (xcd < r ? xcd * (q + 1) : r * (q + 1) + (xcd - r) * q) + off; }
        const int nig = WGM * nN, gid = wgid / nig, fm = gid * WGM, gsz = (nM - fm) < WGM ? (nM - fm) : WGM;
        u.pm = fm + ((wgid % nig) % gsz); u.pn = (wgid % nig) / gsz; return true;
    }
    __device__ __forceinline__ void a_ready(const Unit&) const {}
    __device__ __forceinline__ void done(const Unit&) const {}
};

__device__ __forceinline__ unsigned cvt_pk_bf16(float lo, float hi) { unsigned r; asm volatile("v_cvt_pk_bf16_f32 %0, %1, %2" : "=v"(r) : "v"(lo), "v"(hi)); return r; }
typedef float f32x2 __attribute__((ext_vector_type(2)));
__device__ __forceinline__ f32x2 gelu_pk(f32x2 v) {
    const f32x2 av = __builtin_elementwise_abs(v), d = av * 0.2316418882f + 1.0f;
    f32x2 t; t.x = __builtin_amdgcn_rcpf(d.x); t.y = __builtin_amdgcn_rcpf(d.y);
    f32x2 q = t * 0.5307027145f + (-0.7265760135f); q = q * t + 0.7107068705f; q = q * t + (-0.142248368f); q = q * t + 0.127414796f; q = q * t;
    const f32x2 s = (v * v) * (-0.72134752044f);
    f32x2 e; e.x = __builtin_amdgcn_exp2f(s.x); e.y = __builtin_amdgcn_exp2f(s.y);
    const f32x2 m = v * (q * e), r = v - m;
    f32x2 o; o.x = v.x < 0.f ? m.x : r.x; o.y = v.y < 0.f ? m.y : r.y; return o;
}

template <int ACT  > struct EpiBf16 {
    static constexpr bool PERM = true, AFTER_DRAIN = false; static_assert(ACT == 0 || ACT == 1, "EpiBf16: ACT is 0 (none) or 1 (gelu_pk)");
    bf16_t* O; int ldc; const float* bias; int split_cols; size_t split_stride; float scale0;
    __device__ __forceinline__ void operator()(const f32x4 (&acc)[2][2][4][2], const Unit& u, int wr, int wc, int fr, int fq) const {
        const int row0 = u.pm * BM + wr * 64 + fr; int colt = u.pn * BM; bf16_t* base = O;
        float sc = 1.f; if (split_cols) { const int t = colt / split_cols; base += (size_t)t * split_stride; colt -= t * split_cols; if (t == 0) sc = scale0; }
        const int col0 = colt + wc * 32 + 8 * fq, bcol0 = u.pn * BM + wc * 32 + 8 * fq;
        f32x4 bv[2][2];
#pragma unroll
        for (int bj = 0; bj < 2; ++bj)
#pragma unroll
            for (int n = 0; n < 2; ++n) bv[bj][n] = bias ? *(const f32x4*)(bias + bcol0 + bj * HALF + 4 * n) : (f32x4){0.f, 0.f, 0.f, 0.f};
#pragma unroll
        for (int ai = 0; ai < 2; ++ai)
#pragma unroll
            for (int m = 0; m < 4; ++m) { bf16_t* rowp = base + (size_t)(row0 + ai * HALF + m * 16) * ldc + col0;
#pragma unroll
                for (int bj = 0; bj < 2; ++bj) { f32x4 v0 = acc[ai][bj][m][0] + bv[bj][0], v1 = acc[ai][bj][m][1] + bv[bj][1];
                    if (ACT == 1) { f32x2 a = gelu_pk((f32x2){v0[0], v0[1]}), b = gelu_pk((f32x2){v0[2], v0[3]}), c = gelu_pk((f32x2){v1[0], v1[1]}), d = gelu_pk((f32x2){v1[2], v1[3]});
                        v0 = (f32x4){a.x, a.y, b.x, b.y}; v1 = (f32x4){c.x, c.y, d.x, d.y}; }
                    v0 = v0 * sc; v1 = v1 * sc; u32x4 w; w.x = cvt_pk_bf16(v0[0], v0[1]); w.y = cvt_pk_bf16(v0[2], v0[3]); w.z = cvt_pk_bf16(v1[0], v1[1]); w.w = cvt_pk_bf16(v1[2], v1[3]);
                    *(u32x4*)(rowp + bj * HALF) = w; } }
    }
};
struct EpiBf16S {
    static constexpr bool PERM = true, AFTER_DRAIN = false;
    bf16_t* O; int ldc; int qcols; float scale0; int pn_mask;
    __device__ __forceinline__ void operator()(const f32x4 (&acc)[2][2][4][2], const Unit& u, int wr, int wc, int fr_in, int fq_in) const {
        int l_; asm volatile("v_mbcnt_lo_u32_b32 %0, -1, 0\n\tv_mbcnt_hi_u32_b32 %0, -1, %0" : "=v"(l_)); const int fr = l_ & 15, fq = l_ >> 4; (void)fr_in; (void)fq_in;
        const int row0 = u.pm * BM + wr * 64 + fr; const int colt = (u.pn & pn_mask) * BM;
        const float sc = (colt < qcols) ? scale0 : 1.f;
        const int col0 = colt + wc * 32 + 8 * fq;
#pragma unroll
        for (int ai = 0; ai < 2; ++ai)
#pragma unroll
            for (int m = 0; m < 4; ++m) { bf16_t* rowp = O + (size_t)(row0 + ai * HALF + m * 16) * ldc + col0;
#pragma unroll
                for (int bj = 0; bj < 2; ++bj) { f32x4 v0 = acc[ai][bj][m][0] * sc, v1 = acc[ai][bj][m][1] * sc;
                    u32x4 w; w.x = cvt_pk_bf16(v0[0], v0[1]); w.y = cvt_pk_bf16(v0[2], v0[3]); w.z = cvt_pk_bf16(v1[0], v1[1]); w.w = cvt_pk_bf16(v1[2], v1[3]);
                    *(u32x4*)(rowp + bj * HALF) = w; } }
    }
};
struct EpiResF32 {
    static constexpr bool PERM = true, AFTER_DRAIN = false;
    const float* base; float* out; int ldc; float alpha; float accs;
    __device__ __forceinline__ void operator()(const f32x4 (&acc)[2][2][4][2], const Unit& u, int wr, int wc, int fr_in, int fq_in) const {
        int l_; asm volatile("v_mbcnt_lo_u32_b32 %0, -1, 0\n\tv_mbcnt_hi_u32_b32 %0, -1, %0" : "=v"(l_)); const int fr = l_ & 15, fq = l_ >> 4; (void)fr_in; (void)fq_in;
        const int row0 = u.pm * BM + wr * 64 + fr; const int col0 = u.pn * BM + wc * 32 + 8 * fq;
#pragma unroll
        for (int ai = 0; ai < 2; ++ai)
#pragma unroll
            for (int m = 0; m < 4; ++m) { const size_t off = (size_t)(row0 + ai * HALF + m * 16) * ldc + col0;
#pragma unroll
                for (int bj = 0; bj < 2; ++bj) { const f32x4 b0 = *(const f32x4*)(base + off + bj * HALF), b1 = *(const f32x4*)(base + off + bj * HALF + 4);
                    *(f32x4*)(out + off + bj * HALF) = b0 * alpha + acc[ai][bj][m][0] * accs; *(f32x4*)(out + off + bj * HALF + 4) = b1 * alpha + acc[ai][bj][m][1] * accs; } }
    }
};
struct EpiF32 {
    static constexpr bool PERM = true, AFTER_DRAIN = false;
    float* out; int ldc;
    __device__ __forceinline__ void operator()(const f32x4 (&acc)[2][2][4][2], const Unit& u, int wr, int wc, int fr_in, int fq_in) const {
        int l_; asm volatile("v_mbcnt_lo_u32_b32 %0, -1, 0\n\tv_mbcnt_hi_u32_b32 %0, -1, %0" : "=v"(l_)); const int fr = l_ & 15, fq = l_ >> 4; (void)fr_in; (void)fq_in;
        const int row0 = u.pm * BM + wr * 64 + fr; const int col0 = u.pn * BM + wc * 32 + 8 * fq;
#pragma unroll
        for (int ai = 0; ai < 2; ++ai)
#pragma unroll
            for (int m = 0; m < 4; ++m) { const size_t off = (size_t)(row0 + ai * HALF + m * 16) * ldc + col0;
#pragma unroll
                for (int bj = 0; bj < 2; ++bj) { *(f32x4*)(out + off + bj * HALF) = acc[ai][bj][m][0]; *(f32x4*)(out + off + bj * HALF + 4) = acc[ai][bj][m][1]; } }
    }
};
struct EpiResLnStat {
    static constexpr bool PERM = true, AFTER_DRAIN = false;
    const bf16_t* base; float* out; bf16_t* ob; const float* g; unsigned long long* stat; int ldc; float alpha; float accs;
    __device__ __forceinline__ void operator()(const f32x4 (&acc)[2][2][4][2], const Unit& u, int wr, int wc, int fr_in, int fq_in) const {
        int l_; asm volatile("v_mbcnt_lo_u32_b32 %0, -1, 0\n\tv_mbcnt_hi_u32_b32 %0, -1, %0" : "=v"(l_)); const int fr = l_ & 15, fq = l_ >> 4; (void)fr_in; (void)fq_in;
        const int row0 = u.pm * BM + wr * 64 + fr; const int col0 = u.pn * BM + wc * 32 + 8 * fq;
        f32x4 gv[2][2];
#pragma unroll
        for (int bj = 0; bj < 2; ++bj) { gv[bj][0] = *(const f32x4*)(g + col0 + bj * HALF); gv[bj][1] = *(const f32x4*)(g + col0 + bj * HALF + 4); }
#pragma unroll
        for (int am = 0; am < 4; ++am) { const int ai = am >> 1;
            u32x4 bv[2][2];
#pragma unroll
            for (int mm = 0; mm < 2; ++mm) { const int m = 2 * (am & 1) + mm; const size_t off = (size_t)(row0 + ai * HALF + m * 16) * ldc + col0;
#pragma unroll
                for (int bj = 0; bj < 2; ++bj) bv[mm][bj] = *(const u32x4*)(base + off + bj * HALF); }
#pragma unroll
            for (int mm = 0; mm < 2; ++mm) { const int m = 2 * (am & 1) + mm; const int row = row0 + ai * HALF + m * 16; const size_t off = (size_t)row * ldc + col0; float s1 = 0.f, s2 = 0.f;
#pragma unroll
                for (int bj = 0; bj < 2; ++bj) { const u32x4 bw_ = bv[mm][bj];
                    f32x4 b0, b1; b0[0] = __builtin_bit_cast(float, bw_.x << 16); b0[1] = __builtin_bit_cast(float, bw_.x & 0xffff0000u); b0[2] = __builtin_bit_cast(float, bw_.y << 16); b0[3] = __builtin_bit_cast(float, bw_.y & 0xffff0000u);
                    b1[0] = __builtin_bit_cast(float, bw_.z << 16); b1[1] = __builtin_bit_cast(float, bw_.z & 0xffff0000u); b1[2] = __builtin_bit_cast(float, bw_.w << 16); b1[3] = __builtin_bit_cast(float, bw_.w & 0xffff0000u);
                    const f32x4 y0 = b0 * alpha + acc[ai][bj][m][0] * accs, y1 = b1 * alpha + acc[ai][bj][m][1] * accs;
                    if (out) { *(f32x4*)(out + off + bj * HALF) = y0; *(f32x4*)(out + off + bj * HALF + 4) = y1; }
                    s1 += (y0[0] + y0[1]) + (y0[2] + y0[3]) + (y1[0] + y1[1]) + (y1[2] + y1[3]);
                    s2 += (y0[0] * y0[0] + y0[1] * y0[1]) + (y0[2] * y0[2] + y0[3] * y0[3]) + (y1[0] * y1[0] + y1[1] * y1[1]) + (y1[2] * y1[2] + y1[3] * y1[3]);
                    const f32x4 z0 = y0 * gv[bj][0], z1 = y1 * gv[bj][1];
                    u32x4 w; w.x = cvt_pk_bf16(z0[0], z0[1]); w.y = cvt_pk_bf16(z0[2], z0[3]); w.z = cvt_pk_bf16(z1[0], z1[1]); w.w = cvt_pk_bf16(z1[2], z1[3]);
                    *(u32x4*)(ob + off + bj * HALF) = w; }
                {
                    float a_ = s1, b_ = s1, c_ = s2, d_ = s2;
                    asm volatile("s_nop 1\n\tv_permlane16_swap_b32 %0, %1\n\tv_permlane16_swap_b32 %2, %3\n\ts_nop 1" : "+v"(a_), "+v"(b_), "+v"(c_), "+v"(d_));
                    s1 = a_ + b_; s2 = c_ + d_; a_ = s1; b_ = s1; c_ = s2; d_ = s2;
                    asm volatile("s_nop 1\n\tv_permlane32_swap_b32 %0, %1\n\tv_permlane32_swap_b32 %2, %3\n\ts_nop 1" : "+v"(a_), "+v"(b_), "+v"(c_), "+v"(d_));
                    s1 = a_ + b_; s2 = c_ + d_; }
                if (fq == 0) { atomicAdd(stat + 2 * row, (unsigned long long)(long long)(s1 * 4294967296.f)); atomicAdd(stat + 2 * row + 1, (unsigned long long)(long long)(s2 * 4294967296.f)); } }
        }
    }
};
struct EpiScLn {
    static constexpr bool PERM = true, AFTER_DRAIN = false;
    _Float16* out; int ldc; const long long* stat; const float* cs; const float* bw; float inv_n; float eps;
    __device__ __forceinline__ void operator()(const f32x4 (&acc)[2][2][4][2], const Unit& u, int wr, int wc, int fr_in, int fq_in) const {
        int l_; asm volatile("v_mbcnt_lo_u32_b32 %0, -1, 0\n\tv_mbcnt_hi_u32_b32 %0, -1, %0" : "=v"(l_)); const int fr = l_ & 15, fq = l_ >> 4; (void)fr_in; (void)fq_in;
        const int row0 = u.pm * BM + wr * 64 + fr; const int col0 = u.pn * BM + wc * 32 + 8 * fq;
        f32x4 cv[2][2], bv[2][2];
#pragma unroll
        for (int bj = 0; bj < 2; ++bj) { cv[bj][0] = *(const f32x4*)(cs + col0 + bj * HALF); cv[bj][1] = *(const f32x4*)(cs + col0 + bj * HALF + 4); bv[bj][0] = *(const f32x4*)(bw + col0 + bj * HALF); bv[bj][1] = *(const f32x4*)(bw + col0 + bj * HALF + 4); }
        long long st[2][4][2];
#pragma unroll
        for (int ai = 0; ai < 2; ++ai)
#pragma unroll
            for (int m = 0; m < 4; ++m) { const int row = row0 + ai * HALF + m * 16; st[ai][m][0] = stat[2 * row]; st[ai][m][1] = stat[2 * row + 1]; }
#pragma unroll
        for (int ai = 0; ai < 2; ++ai)
#pragma unroll
            for (int m = 0; m < 4; ++m) { const int row = row0 + ai * HALF + m * 16; const size_t off = (size_t)row * ldc + col0;
                const float s1 = (float)st[ai][m][0] * 2.3283064365386963e-10f, s2 = (float)st[ai][m][1] * 2.3283064365386963e-10f; const float mu = s1 * inv_n, var = s2 * inv_n - mu * mu; const float rstd = 1.f / __builtin_sqrtf(var + eps), mr = mu * rstd;
#pragma unroll
                for (int bj = 0; bj < 2; ++bj) { const f32x4 v0 = acc[ai][bj][m][0] * rstd - cv[bj][0] * mr + bv[bj][0], v1 = acc[ai][bj][m][1] * rstd - cv[bj][1] * mr + bv[bj][1];
                    typedef _Float16 h8 __attribute__((ext_vector_type(8))); typedef float f8 __attribute__((ext_vector_type(8)));
                    const f8 vv = {v0[0], v0[1], v0[2], v0[3], v1[0], v1[1], v1[2], v1[3]};
                    *(h8*)(out + off + bj * HALF) = __builtin_convertvector(vv, h8); } }
    }
};
struct StackOrder {
    StaticOrder S;
    __host__ __device__ void init(int M, int N, int G_, int c_) { S.init(M, N, G_, c_); }
    __host__ __device__ bool next(int i, Unit& u) const { if (!S.next(i, u)) return false; u.pn += (u.pm >> 3) * 8; return true; }
    __device__ __forceinline__ void a_ready(const Unit&) const {}
    __device__ __forceinline__ void done(const Unit&) const {}
};
template <class Epi, class Sched, bool ALIGN_EPI = false, bool SP2 = false>
__device__ __forceinline__ void gemm_phase(PG8_LAS unsigned char* lds, const Gemm g, const Sched& S, const Epi& E, const int wave_id) {
    int lane_; asm volatile("v_mbcnt_lo_u32_b32 %0, -1, 0\n\tv_mbcnt_hi_u32_b32 %0, -1, %0" : "=v"(lane_));
    const int wid = wave_id, lane = lane_, tid = wid * 64 + lane, wr = wid >> 2, wc = wid & 3, fr = lane & 15, fq = lane >> 4;
    const int K = g.K, nt = g.kdiag ? 4 : K / BK;
    unsigned voffA[2], voffB[2];
#pragma unroll
    for (int i = 0; i < 2; ++i) { int R, C; stage_rc(tid * 16 + i * 8192, R, C); const int Rb = Epi::PERM ? ((R & ~31) + perm32(R & 31)) : R;
        voffA[i] = (unsigned)(R * K + C) * 2u; voffB[i] = (unsigned)(Rb * K + C) * 2u; }
    const size_t kstep = (size_t)(BK * 2);
    const size_t hstep = (size_t)HALF * K * 2;
    const size_t tstep = 2 * hstep;
    const unsigned ldsw = (unsigned)wid * 1024u;
    const int aoff = lds_byte(wr * 64 + fr, fq * 8), boff = lds_byte(wc * 32 + fr, fq * 8);
#define PG8_SA(b, h) (((b) * 2 + (h)) * HTB)
#define PG8_SB(b, h) ((4 + (b) * 2 + (h)) * HTB)
#define PG8_STAGE(bufoff, gbase, voff) do { _Pragma("unroll") for (int _i = 0; _i < 2; ++_i) \
        __builtin_amdgcn_global_load_lds((const unsigned*)((const char*)(gbase) + (voff)[_i]), (PG8_LAS unsigned*)(lds + (bufoff) + ldsw + _i * 8192), 16, 0, 0); } while (0)
#define PG8_LDA(dst, b, h) do { _Pragma("unroll") for (int m = 0; m < 4; ++m) _Pragma("unroll") for (int k = 0; k < 2; ++k) dst[m][k] = *(const PG8_LAS bf16x8*)(lds + PG8_SA(b, h) + aoff + m * 2048 + k * 1024); } while (0)
#define PG8_LDB(dst, b, h) do { _Pragma("unroll") for (int n = 0; n < 2; ++n) _Pragma("unroll") for (int k = 0; k < 2; ++k) dst[n][k] = *(const PG8_LAS bf16x8*)(lds + PG8_SB(b, h) + boff + n * 2048 + k * 1024); } while (0)
#define PG8_MMA(ai, bj, At, Bt) do { __builtin_amdgcn_s_setprio(1); _Pragma("unroll") for (int m = 0; m < 4; ++m) _Pragma("unroll") for (int n = 0; n < 2; ++n) _Pragma("unroll") for (int k = 0; k < 2; ++k) \
        acc[ai][bj][m][n] = __builtin_amdgcn_mfma_f32_16x16x32_bf16(Bt[n][k], At[m][k], acc[ai][bj][m][n], 0, 0, 0); __builtin_amdgcn_s_setprio(0); } while (0)
#define PG8_WAIT_V(n) asm volatile("s_waitcnt vmcnt(" #n ")" ::: "memory")
#define PG8_WAIT_L(n) asm volatile("s_waitcnt lgkmcnt(" #n ")" ::: "memory")
#define PG8_BAR __builtin_amdgcn_s_barrier()
#define PG8_SCHED __builtin_amdgcn_sched_barrier(0)
    Unit cur, nxt; int ui = 0;
    if (!S.next(0, cur)) return;
    f32x4 acc[2][2][4][2];
#pragma unroll
    for (int a = 0; a < 2; ++a)
#pragma unroll
        for (int b = 0; b < 2; ++b)
#pragma unroll
            for (int m = 0; m < 4; ++m)
#pragma unroll
                for (int n = 0; n < 2; ++n) acc[a][b][m][n] = (f32x4){0.f, 0.f, 0.f, 0.f};
    bf16x8 At[4][2], B0[2][2], B1[2][2];
    const char* cA = (const char*)g.A + (size_t)cur.pm * tstep + (g.kdiag ? (size_t)(cur.pm & 7) * 512 : (size_t)0); const char* cB = (const char*)g.Bt + (size_t)cur.pn * tstep + (g.kdiag ? (size_t)(cur.pm & 7) * 512 : (size_t)0);
    S.a_ready(cur);
    if constexpr (SP2) {
        PG8_STAGE(PG8_SB(0, 0), cB, voffB); PG8_STAGE(PG8_SB(0, 1), cB + hstep, voffB); PG8_STAGE(PG8_SA(0, 0), cA, voffA); PG8_STAGE(PG8_SA(0, 1), cA + hstep, voffA);
        if (wr == 1) PG8_BAR;
        PG8_WAIT_V(2); PG8_BAR;
        PG8_STAGE(PG8_SB(1, 0), cB + kstep, voffB); PG8_STAGE(PG8_SA(1, 0), cA + kstep, voffA); PG8_STAGE(PG8_SB(1, 1), cB + hstep + kstep, voffB);
        PG8_WAIT_V(6); PG8_BAR;
    } else {
        PG8_STAGE(PG8_SB(0, 0), cB, voffB); PG8_STAGE(PG8_SA(0, 0), cA, voffA); PG8_STAGE(PG8_SB(0, 1), cB + hstep, voffB); PG8_STAGE(PG8_SA(0, 1), cA + hstep, voffA);
        if (wr == 1) PG8_BAR;
        PG8_WAIT_V(4); PG8_BAR;
        PG8_STAGE(PG8_SB(1, 0), cB + kstep, voffB); PG8_STAGE(PG8_SA(1, 0), cA + kstep, voffA); PG8_STAGE(PG8_SB(1, 1), cB + hstep + kstep, voffB);
        PG8_WAIT_V(6); PG8_BAR;
    }
    for (;;) {
        const bool has_next = S.next(ui + 1, nxt);
        const size_t nkd = (g.kdiag && has_next) ? (size_t)(nxt.pm & 7) * 512 : (size_t)0; const char* nA = has_next ? (const char*)g.A + (size_t)nxt.pm * tstep + nkd : cA; const char* nB = has_next ? (const char*)g.Bt + (size_t)nxt.pn * tstep + nkd : cB;
        for (int t = 0; t < nt; t += 2) {
            const bool last = (t == nt - 2);
            const char* a1 = cA + (size_t)(t + 1) * kstep;
            const char* a2 = last ? nA : cA + (size_t)(t + 2) * kstep; const char* b2 = last ? nB : cB + (size_t)(t + 2) * kstep;
            const char* a3 = a2 + kstep; const char* b3 = b2 + kstep;
            if (last && has_next) S.a_ready(nxt);
            if constexpr (SP2) {
            PG8_LDB(B0, 0, 0); PG8_LDB(B1, 0, 1); PG8_SCHED; PG8_LDA(At, 0, 0); PG8_STAGE(PG8_SA(1, 1), a1 + hstep, voffA);
            PG8_WAIT_V(8); PG8_WAIT_L(0); PG8_BAR; PG8_MMA(0, 0, At, B0); PG8_MMA(0, 1, At, B1); PG8_BAR; PG8_SCHED;
            PG8_LDA(At, 0, 1); PG8_STAGE(PG8_SB(0, 0), b2, voffB); PG8_STAGE(PG8_SB(0, 1), b2 + hstep, voffB); PG8_STAGE(PG8_SA(0, 0), a2, voffA);
            PG8_WAIT_V(8); PG8_WAIT_L(0); PG8_BAR; PG8_MMA(1, 0, At, B0); PG8_MMA(1, 1, At, B1); PG8_BAR; PG8_SCHED;
            PG8_LDB(B0, 1, 0); PG8_LDB(B1, 1, 1); PG8_SCHED; PG8_LDA(At, 1, 0); PG8_STAGE(PG8_SA(0, 1), a2 + hstep, voffA);
            PG8_WAIT_V(8); PG8_WAIT_L(0); PG8_BAR; PG8_MMA(0, 0, At, B0); PG8_MMA(0, 1, At, B1); PG8_BAR; PG8_SCHED;
            PG8_LDA(At, 1, 1); PG8_STAGE(PG8_SB(1, 0), b3, voffB); PG8_STAGE(PG8_SB(1, 1), b3 + hstep, voffB); PG8_STAGE(PG8_SA(1, 0), a3, voffA);
            PG8_WAIT_V(8); PG8_WAIT_L(0); PG8_BAR; PG8_MMA(1, 0, At, B0); PG8_MMA(1, 1, At, B1); PG8_BAR; PG8_SCHED;
            } else {
            PG8_LDB(B0, 0, 0); PG8_SCHED; PG8_LDA(At, 0, 0); PG8_STAGE(PG8_SA(1, 1), a1 + hstep, voffA);
            PG8_WAIT_L(8); PG8_BAR; PG8_WAIT_L(0); PG8_MMA(0, 0, At, B0); PG8_BAR; PG8_SCHED;
            PG8_LDB(B1, 0, 1); PG8_STAGE(PG8_SB(0, 0), b2, voffB);
            PG8_BAR; PG8_WAIT_L(0); PG8_MMA(0, 1, At, B1); PG8_BAR;
            PG8_LDA(At, 0, 1); PG8_STAGE(PG8_SA(0, 0), a2, voffA);
            PG8_BAR; PG8_WAIT_L(0); PG8_MMA(1, 0, At, B0); PG8_BAR; PG8_SCHED;
            PG8_STAGE(PG8_SB(0, 1), b2 + hstep, voffB);
            PG8_WAIT_V(6); PG8_BAR; PG8_MMA(1, 1, At, B1); PG8_BAR;
            PG8_LDB(B0, 1, 0); PG8_SCHED; PG8_LDA(At, 1, 0); PG8_STAGE(PG8_SA(0, 1), a2 + hstep, voffA);
            PG8_WAIT_L(8); PG8_BAR; PG8_WAIT_L(0); PG8_MMA(0, 0, At, B0); PG8_BAR; PG8_SCHED;
            PG8_LDB(B1, 1, 1); PG8_STAGE(PG8_SB(1, 0), b3, voffB);
            PG8_BAR; PG8_WAIT_L(0); PG8_MMA(0, 1, At, B1); PG8_BAR;
            PG8_LDA(At, 1, 1); PG8_STAGE(PG8_SA(1, 0), a3, voffA);
            PG8_BAR; PG8_WAIT_L(0); PG8_MMA(1, 0, At, B0); PG8_BAR; PG8_SCHED;
            PG8_STAGE(PG8_SB(1, 1), b3 + hstep, voffB);
            PG8_WAIT_V(6); PG8_BAR; PG8_MMA(1, 1, At, B1); PG8_BAR;
            }
        }
        if constexpr (ALIGN_EPI) { if (wr == 0) PG8_BAR; }
        if constexpr (!Epi::AFTER_DRAIN) { E(acc, cur, wr, wc, fr, fq); S.done(cur); }
        if (!has_next) break;
#pragma unroll
        for (int a = 0; a < 2; ++a)
#pragma unroll
            for (int b = 0; b < 2; ++b)
#pragma unroll
                for (int m = 0; m < 4; ++m)
#pragma unroll
                    for (int n = 0; n < 2; ++n) acc[a][b][m][n] = (f32x4){0.f, 0.f, 0.f, 0.f};
        cur = nxt; cA = nA; cB = nB; ++ui;
        if constexpr (ALIGN_EPI) { if (wr == 1) PG8_BAR; }
    }
    PG8_WAIT_V(0);
    if constexpr (!ALIGN_EPI) { if (wr == 0) PG8_BAR; }
    PG8_BAR;
    if constexpr (Epi::AFTER_DRAIN) { E.fused(acc, cur, wr, wc, fr, fq, lds, wid, lane); S.done(cur); }
#undef PG8_SA
#undef PG8_SB
#undef PG8_STAGE
#undef PG8_LDA
#undef PG8_LDB
#undef PG8_MMA
#undef PG8_WAIT_V
#undef PG8_WAIT_L
#undef PG8_BAR
#undef PG8_SCHED
}
}

#ifndef STOP_AFTER
#define STOP_AFTER -1
#endif
#ifndef COPY_SRC
#define COPY_SRC 0
#endif
#ifndef U_FP4
#define U_FP4 1
#endif
#ifndef V_FP4
#define V_FP4 1
#endif
#ifndef PEER_DRY
#define PEER_DRY 3
#endif
#ifndef DA_CMAX
#define DA_CMAX 56
#endif
#ifndef P0_RPT
#define P0_RPT 0
#endif
#ifndef TABLE_FILL
#define TABLE_FILL 1
#endif
#ifndef FILL_TAB
#define FILL_TAB 0
#endif
#ifndef PEER_BANDS
#define PEER_BANDS 8
#endif
#ifndef U_I4
#define U_I4 1
#endif
#ifndef U_CHUNKED
#define U_CHUNKED 1
#endif
#ifndef RPT_MASK
#define RPT_MASK 0
#endif
#ifndef PROBE_MASK
#define PROBE_MASK 0
#endif
#ifndef DIAG_LAYER
#define DIAG_LAYER 0
#endif
#ifndef DIAG_A
#define DIAG_A 0
#endif
#ifndef DIAG_B
#define DIAG_B 2
#endif
#ifndef PEER_HS
#define PEER_HS 0x4444
#endif
constexpr int NWAVES = 8;
constexpr int T = 8192, D = 2048, DEPTH = 4;
constexpr int A_QKV = 2560, B_QKV = 6144;
constexpr int NE = 16384;
constexpr float LN_EPS = 1e-5f;
constexpr float ALPHA = 1.6817928305074290f;
constexpr float LOG2E = 1.4426950408889634f;
constexpr float C2 = 0.125f * LOG2E;
constexpr float NEGBIG = -1e30f;
constexpr int N_PHASES = 2 + 6 * DEPTH;

constexpr size_t MiB = 1u << 20;
constexpr size_t WS_CTL = 0, CTL_ZERO_BYTES = 2 * MiB;
constexpr size_t WS_WQKVA = 2 * MiB;
constexpr size_t WS_WQKVB = WS_WQKVA + 20 * MiB;
constexpr size_t WS_WO    = WS_WQKVB + 48 * MiB;
constexpr size_t WS_WEFF  = WS_WO + 32 * MiB;
constexpr size_t WS_ABLK  = WS_WEFF + 32 * MiB;
constexpr size_t WS_WQB   = WS_ABLK + 32 * MiB;
constexpr size_t WS_XB    = WS_WQB + 32 * MiB;
constexpr size_t WS_XF    = WS_XB + 32 * MiB;
constexpr size_t WS_YF    = WS_XF + 64 * MiB;
constexpr size_t WS_QKV   = WS_YF + 64 * MiB;
constexpr size_t WS_OB    = WS_QKV + 96 * MiB;
constexpr size_t WS_SC    = WS_OB + 32 * MiB;
constexpr size_t WS_STASH = WS_SC + 64 * MiB;
constexpr size_t WS_UT    = WS_STASH + 32 * MiB;
constexpr size_t WS_VT    = WS_UT + 128 * MiB;
constexpr size_t WS_US    = WS_VT + 128 * MiB;
constexpr size_t WS_VS    = WS_US + 1 * MiB;
constexpr size_t WS_CSW   = WS_VS + 1 * MiB;
constexpr size_t WS_END   = WS_CSW + 1 * MiB;
constexpr int CW_TMO = 0, CW_CODE = 1;
constexpr int CW_DA = 2048;
constexpr int CW_CVT = 1024;
constexpr size_t WS_STAT = 1 * MiB;
constexpr int CW_BAR = 4096;

constexpr int RING_OFF = 0, RING_BYTES = 131072;
constexpr int LDSCTL_OFF = RING_BYTES, MISC_OFF = LDSCTL_OFF + 320;
constexpr int LDS_BYTES = 147456;

#define GAS __attribute__((address_space(1)))
#define LAS __attribute__((address_space(3)))
typedef unsigned short bf16;
typedef unsigned v4u __attribute__((ext_vector_type(4)));
typedef unsigned v2u __attribute__((ext_vector_type(2)));
typedef unsigned v3u __attribute__((ext_vector_type(3)));
typedef unsigned v6u __attribute__((ext_vector_type(6)));
typedef float f32x32 __attribute__((ext_vector_type(32)));
typedef float f32x4 __attribute__((ext_vector_type(4)));
typedef float f32x16 __attribute__((ext_vector_type(16)));
typedef short bf16x8 __attribute__((ext_vector_type(8)));
typedef short s16x4 __attribute__((ext_vector_type(4)));
typedef __bf16 bf16x2_t __attribute__((ext_vector_type(2)));
typedef GAS unsigned gu32;
#define RLX_AGENT __ATOMIC_RELAXED, __HIP_MEMORY_SCOPE_AGENT
#define LDS_WAIT() asm volatile("s_waitcnt lgkmcnt(0)" ::: "memory")
#define VM_WAIT() asm volatile("s_waitcnt vmcnt(0)" ::: "memory")
typedef float f32x2_t __attribute__((ext_vector_type(2)));
__device__ __forceinline__ unsigned pkbf(float lo, float hi) { const f32x2_t v = {lo, hi}; const bf16x2_t b = __builtin_convertvector(v, bf16x2_t); return __builtin_bit_cast(unsigned, b); }
#define MFMA32(a, b, c) __builtin_amdgcn_mfma_f32_32x32x16_bf16(a, b, c, 0, 0, 0)
__device__ __forceinline__ int lane_id() { int l; asm volatile("v_mbcnt_lo_u32_b32 %0, -1, 0\n\tv_mbcnt_hi_u32_b32 %0, -1, %0" : "=v"(l)); return l; }
__device__ __forceinline__ int opaque_u(int x) { int v; asm volatile("v_mov_b32 %0, %1" : "=v"(v) : "s"(x)); return __builtin_amdgcn_readfirstlane(v); }
#define XB_TMO      128
#define XB_XCNT(j)  (256  + 64 * (j))
#define XB_XSUB(j)  (1280 + 64 * (j))
#define XB_XGEN(j)  (2304 + 64 * (j))
#define XB_TOP      3328
#define XB_TOPGEN   3392
#define XCD_BAR_WORDS 3456
#define XB_SPIN_CAP (1u << 21)

__device__ __forceinline__ unsigned xb_ld(unsigned* p)              { return __hip_atomic_load(p, __ATOMIC_RELAXED, __HIP_MEMORY_SCOPE_AGENT); }
__device__ __forceinline__ unsigned xb_add(unsigned* p, unsigned v) { return __hip_atomic_fetch_add(p, v, __ATOMIC_RELAXED, __HIP_MEMORY_SCOPE_AGENT); }
__device__ __forceinline__ unsigned xb_xcc_id() { return (unsigned)__builtin_amdgcn_s_getreg((3 << 11) | 20) & 0xFu; }
#define XB_SPIN(cond, bar) do { unsigned _sp = 0; while (cond) { __builtin_amdgcn_s_sleep(1); \
    if ((++_sp & 255u) == 0u) { if (xb_ld(&(bar)[XB_TMO])) break; if (_sp > XB_SPIN_CAP) { atomicAdd(&(bar)[XB_TMO], 1u); break; } } } } while (0)

struct XcdBarrier {
    unsigned* bar; unsigned x; int wave;
    volatile LAS unsigned* st;
};

__device__ __forceinline__ XcdBarrier xcd_barrier_post(unsigned* bar, volatile LAS unsigned* st) {
    XcdBarrier b; b.bar = bar; b.x = xb_xcc_id(); b.st = st; b.wave = __builtin_amdgcn_readfirstlane((int)(threadIdx.x >> 6));
    if (threadIdx.x == 0) (void)xb_add(&bar[XB_XCNT(b.x)], 1u);
    return b;
}
__device__ __forceinline__ void xcd_barrier_complete(unsigned* bar, unsigned x, unsigned& nloc, unsigned& nx) {
    const unsigned G = gridDim.x * gridDim.y * gridDim.z;
    unsigned sum, cnt, mine, sp = 0u;
    for (;;) {
        sum = 0u; cnt = 0u; mine = 0u;
#pragma unroll
        for (unsigned j = 0; j < 16; ++j) { const unsigned c = xb_ld(&bar[XB_XCNT(j)]); sum += c; cnt += (c > 0u) ? 1u : 0u; mine = (j == x) ? c : mine; }
        if (sum == G) break;
        __builtin_amdgcn_s_sleep(1);
        if ((++sp & 255u) == 0u) { if (xb_ld(&bar[XB_TMO])) break; if (sp > XB_SPIN_CAP) { atomicAdd(&bar[XB_TMO], 1u); break; } }
    }
    nloc = mine > 0u ? mine : 1u; nx = cnt > 0u ? cnt : 1u;
}

__device__ __forceinline__ void xcd_barrier(const XcdBarrier& b) {
    asm volatile("s_waitcnt vmcnt(0)" ::: "memory");
    __syncthreads();
    if (b.wave == 0 && lane_id() == 0) {
        unsigned* bar = b.bar;
        __builtin_amdgcn_s_waitcnt(0);
        unsigned nloc = b.st[0], nx = b.st[1];
        if (nloc == 0u) { xcd_barrier_complete(bar, b.x, nloc, nx); b.st[0] = nloc; b.st[1] = nx; }
        const unsigned old = xb_add(&bar[XB_XSUB(b.x)], 1u);
        const unsigned gen = old / nloc;
        if (old + 1u == (gen + 1u) * nloc) {
            __builtin_amdgcn_fence(__ATOMIC_RELEASE, "agent");
            asm volatile("s_waitcnt vmcnt(0)" ::: "memory");
            const unsigned og = xb_add(&bar[XB_TOP], 1u);
            const unsigned tg = og / nx;
            if (og + 1u == (tg + 1u) * nx) xb_add(&bar[XB_TOPGEN], 1u);
            else XB_SPIN(xb_ld(&bar[XB_TOPGEN]) == tg, bar);
            __builtin_amdgcn_fence(__ATOMIC_ACQUIRE, "agent");
            xb_add(&bar[XB_XGEN(b.x)], 1u);
            asm volatile("s_waitcnt vmcnt(0)" ::: "memory");
        } else {
            XB_SPIN(xb_ld(&bar[XB_XGEN(b.x)]) == gen, bar);
            __builtin_amdgcn_fence(__ATOMIC_ACQUIRE, "agent");
            asm volatile("s_waitcnt vmcnt(0)" ::: "memory");
        }
    }
    __syncthreads();
}

struct Frame {
    LAS unsigned char* lds;
    int wave;
    int vcu, G;
};
constexpr int PT_OFF = LDSCTL_OFF + 1024, PT_OUT = 19, PT_WS = 20;
__device__ __forceinline__ unsigned long long ldp_raw(const Frame& F, int k) {
    const unsigned long long v = *(volatile LAS unsigned long long*)(F.lds + PT_OFF + 8 * k);
    const unsigned lo = __builtin_amdgcn_readfirstlane((unsigned)v), hi = __builtin_amdgcn_readfirstlane((unsigned)(v >> 32));
    return ((unsigned long long)hi << 32) | lo;
}
__device__ __forceinline__ const float* ldin(const Frame& F, int k) { return (const float*)ldp_raw(F, k); }
__device__ __forceinline__ unsigned char* ldws(const Frame& F) { return (unsigned char*)ldp_raw(F, PT_WS); }
#define DPPF(x, ctrl) __builtin_bit_cast(float, __builtin_amdgcn_update_dpp(0, __builtin_bit_cast(int, (float)(x)), (ctrl), 0xF, 0xF, false))
__device__ __forceinline__ float xor1f(float x) { return DPPF(x, 0xB1); }
__device__ __forceinline__ float xor2f(float x) { return DPPF(x, 0x4E); }
__device__ __forceinline__ float xor4f(float x) { const float t = DPPF(x, 0x141); return DPPF(t, 0x1B); }
__device__ __forceinline__ float xor8f(float x) { return DPPF(x, 0x128); }
__device__ __forceinline__ float swapsum16(float a, float b) { asm volatile("s_nop 1\n\tv_permlane16_swap_b32 %0, %1\n\ts_nop 1" : "+v"(a), "+v"(b)); return a + b; }
__device__ __forceinline__ float swapsum32(float a, float b) { asm volatile("s_nop 1\n\tv_permlane32_swap_b32 %0, %1\n\ts_nop 1" : "+v"(a), "+v"(b)); return a + b; }
__device__ __forceinline__ float wave_sum(float v) {
    v += xor1f(v); v += xor2f(v); v += xor4f(v); v += xor8f(v); v = swapsum16(v, v); v = swapsum32(v, v);
    return v;
}
__device__ __forceinline__ float wave_max_all(float v) {
    v = fmaxf(v, xor1f(v)); v = fmaxf(v, xor2f(v)); v = fmaxf(v, xor4f(v)); v = fmaxf(v, xor8f(v));
    { float a = v, c = v; asm volatile("s_nop 1\n\tv_permlane16_swap_b32 %0, %1\n\ts_nop 1" : "+v"(a), "+v"(c)); v = fmaxf(a, c); }
    { float a = v, c = v; asm volatile("s_nop 1\n\tv_permlane32_swap_b32 %0, %1\n\ts_nop 1" : "+v"(a), "+v"(c)); v = fmaxf(a, c); }
    return v;
}
__device__ __forceinline__ float bf_lo(unsigned w) { return __builtin_bit_cast(float, w << 16); }
__device__ __forceinline__ float bf_hi(unsigned w) { return __builtin_bit_cast(float, w & 0xffff0000u); }

__device__ __forceinline__ void p0_transpose_item(const float* W, int K, int N, bf16* WT, LAS float* scr, int item, int lane) {
    const int nblk = N / 32, kb = item / nblk, nb = item % nblk, k0 = 64 * kb, n0 = 32 * nb;
    float tv[32];
#pragma unroll
    for (int i = 0; i < 32; ++i) tv[i] = W[(size_t)(k0 + 2 * i + (lane >> 5)) * N + n0 + (lane & 31)];
#pragma unroll
    for (int i = 0; i < 32; ++i) scr[(2 * i + (lane >> 5)) * 33 + (lane & 31)] = tv[i];
    LDS_WAIT(); asm volatile("" ::: "memory");
    const int c = lane & 7;
#pragma unroll
    for (int j = 0; j < 4; ++j) { const int n = (lane >> 3) + 8 * j; const LAS float* s = scr + (8 * c) * 33 + n;
        v4u o; o.x = pkbf(s[0 * 33], s[1 * 33]); o.y = pkbf(s[2 * 33], s[3 * 33]); o.z = pkbf(s[4 * 33], s[5 * 33]); o.w = pkbf(s[6 * 33], s[7 * 33]);
        *(GAS v4u*)(WT + (size_t)(n0 + n) * K + k0 + 8 * c) = o; }
    LDS_WAIT(); asm volatile("" ::: "memory");
}
__device__ __forceinline__ void cvt_stream(const float* src, bf16* dst, size_t n8, size_t gt, size_t GT) {
    const GAS f32x4* s = (const GAS f32x4*)src; GAS v4u* d = (GAS v4u*)dst;
    size_t i = gt;
    for (; i + 3 * GT < n8; i += 4 * GT) {
        f32x4 a[4], c[4];
#pragma unroll
        for (int u = 0; u < 4; ++u) { a[u] = __builtin_nontemporal_load(s + 2 * (i + u * GT)); c[u] = __builtin_nontemporal_load(s + 2 * (i + u * GT) + 1); }
#pragma unroll
        for (int u = 0; u < 4; ++u) { v4u o; o.x = pkbf(a[u].x, a[u].y); o.y = pkbf(a[u].z, a[u].w); o.z = pkbf(c[u].x, c[u].y); o.w = pkbf(c[u].z, c[u].w); d[i + u * GT] = o; }
    }
    for (; i < n8; i += GT) { const f32x4 a0 = s[2 * i], b0 = s[2 * i + 1]; v4u o0; o0.x = pkbf(a0.x, a0.y); o0.y = pkbf(a0.z, a0.w); o0.z = pkbf(b0.x, b0.y); o0.w = pkbf(b0.z, b0.w); d[i] = o0; }
}
__device__ __forceinline__ unsigned enc_e2m3(float x) {
    const unsigned ub = __builtin_bit_cast(unsigned, x), ua = ub & 0x7fffffffu; const float a = __builtin_bit_cast(float, ua);
    unsigned r;
    if (a >= 1.0f) { const unsigned u = ua + 0x7FFFFu + ((ua >> 20) & 1u); r = (u >> 20) - (127u << 3) + 8u; }
    else r = (unsigned)__builtin_rintf(a * 8.f);
    r = r > 31u ? 31u : r;
    return r | ((ub >> 26) & 32u);
}
__device__ __forceinline__ unsigned dpp_quad(unsigned v, int sel) {
    return sel == 0 ? (unsigned)__builtin_amdgcn_mov_dpp((int)v, 0x00, 0xF, 0xF, true) : sel == 1 ? (unsigned)__builtin_amdgcn_mov_dpp((int)v, 0x55, 0xF, 0xF, true)
         : sel == 2 ? (unsigned)__builtin_amdgcn_mov_dpp((int)v, 0xAA, 0xF, 0xF, true) : (unsigned)__builtin_amdgcn_mov_dpp((int)v, 0xFF, 0xF, 0xF, true); }
__device__ __forceinline__ void row_scale(float am, float target, float& sc, float& isc) {
    sc = 1.f; isc = 1.f;
    if (am > 1e-30f) { const float q = target / am; int ex = (int)((__builtin_bit_cast(unsigned, q) >> 23) & 255u) - 127; ex = ex > 60 ? 60 : (ex < -60 ? -60 : ex);
        sc = __builtin_bit_cast(float, (unsigned)(ex + 127) << 23); isc = __builtin_bit_cast(float, (unsigned)(127 - ex) << 23); }
}
#ifndef FP6_HW
#define FP6_HW 1
#endif
__device__ __forceinline__ void cvt_rows_fp6(const float* src, unsigned char* dst, float* inv, int nrows, int gw, int NGW, int lane) {
    f32x4 nx[8];
    if (gw < nrows) { const GAS f32x4* s = (const GAS f32x4*)(src + (size_t)gw * D) + lane * 8;
#pragma unroll
        for (int q = 0; q < 8; ++q) nx[q] = s[q]; }
    for (int r = gw; r < nrows; r += NGW) {
        f32x4 v[8]; float am = 0.f;
#pragma unroll
        for (int q = 0; q < 8; ++q) v[q] = nx[q];
        { const int rn = r + NGW; if (rn < nrows) { const GAS f32x4* s = (const GAS f32x4*)(src + (size_t)rn * D) + lane * 8;
#pragma unroll
            for (int q = 0; q < 8; ++q) nx[q] = s[q]; } }
#pragma unroll
        for (int q = 0; q < 8; ++q) am = fmaxf(am, fmaxf(fmaxf(fabsf(v[q].x), fabsf(v[q].y)), fmaxf(fabsf(v[q].z), fabsf(v[q].w))));
#pragma unroll
        for (int o = 1; o < 64; o <<= 1) am = fmaxf(am, __shfl_xor(am, o));
        float sc, isc; row_scale(am, 7.5f, sc, isc);
        v6u w; bool ok = false;
#if FP6_HW
        {
            f32x16 ev, od;
#pragma unroll
            for (int i = 0; i < 16; ++i) { ev[i] = v[i >> 1][(2 * i) & 3]; od[i] = v[i >> 1][(2 * i + 1) & 3]; }
            w = __builtin_amdgcn_cvt_scalef32_2xpk16_fp6_f32(ev, od, isc);
            const f32x32 back = __builtin_amdgcn_cvt_scalef32_pk32_f32_fp6(w, isc);
            const float tol = am * 0.07f + 1e-30f; bool good = true;
#pragma unroll
            for (int j = 0; j < 32; ++j) good = good && (fabsf(back[j] - v[j >> 2][j & 3]) <= tol);
            ok = __all(good);
        }
#endif
        if (!ok) {
            unsigned ww[6] = {0u, 0u, 0u, 0u, 0u, 0u};
#pragma unroll
            for (int j = 0; j < 32; ++j) { const unsigned c = enc_e2m3(v[j >> 2][j & 3] * sc); const int bp = 6 * j, wd = bp >> 5, of = bp & 31; ww[wd] |= c << of; if (of > 26) ww[wd + 1] |= c >> (32 - of); }
#pragma unroll
            for (int k = 0; k < 6; ++k) w[k] = ww[k];
        }
        GAS unsigned* o = (GAS unsigned*)(dst + (size_t)r * 1536 + lane * 24);
#pragma unroll
        for (int k = 0; k < 6; ++k) o[k] = w[k];
        if (lane == 0) inv[r] = isc;
    }
}
__device__ __forceinline__ unsigned enc_e2m1(float x) {
    const unsigned ub = __builtin_bit_cast(unsigned, x), ua = ub & 0x7fffffffu; const float a = __builtin_bit_cast(float, ua);
    unsigned r;
    if (a >= 1.0f) { const unsigned u = ua + 0x1FFFFFu + ((ua >> 22) & 1u); r = (u >> 22) - (127u << 1) + 2u; }
    else r = (unsigned)__builtin_rintf(a * 2.f);
    r = r > 7u ? 7u : r;
    return r | ((ub >> 28) & 8u);
}
#ifndef FP4_HW
#define FP4_HW 1
#endif
__device__ __forceinline__ void cvt_rows_fp4(const float* src, unsigned char* dst, float* inv, int nrows, int gw, int NGW, int lane) {
    f32x4 nx[8];
    if (gw < nrows) { const GAS f32x4* s = (const GAS f32x4*)(src + (size_t)gw * D) + 2 * lane;
#pragma unroll
        for (int q = 0; q < 4; ++q) { nx[2 * q] = __builtin_nontemporal_load(s + 128 * q); nx[2 * q + 1] = __builtin_nontemporal_load(s + 128 * q + 1); } }
    for (int r = gw; r < nrows; r += NGW) {
        f32x4 v[8]; float am = 0.f;
#pragma unroll
        for (int q = 0; q < 8; ++q) v[q] = nx[q];
        { const int rn = r + NGW; if (rn < nrows) { const GAS f32x4* s = (const GAS f32x4*)(src + (size_t)rn * D) + 2 * lane;
#pragma unroll
            for (int q = 0; q < 4; ++q) { nx[2 * q] = __builtin_nontemporal_load(s + 128 * q); nx[2 * q + 1] = __builtin_nontemporal_load(s + 128 * q + 1); } } }
#pragma unroll
        for (int q = 0; q < 8; ++q) am = fmaxf(am, fmaxf(fmaxf(fabsf(v[q].x), fabsf(v[q].y)), fmaxf(fabsf(v[q].z), fabsf(v[q].w))));
#pragma unroll
        for (int o = 1; o < 64; o <<= 1) am = fmaxf(am, __shfl_xor(am, o));
        float sc, isc; row_scale(am, 6.f, sc, isc);
        unsigned w[4]; bool ok = false;
#if FP4_HW
        {
#pragma unroll
            for (int q = 0; q < 4; ++q) { unsigned t = 0u;
                t = __builtin_amdgcn_cvt_scalef32_pk_fp4_f32(t, v[2 * q].x, v[2 * q].y, isc, 0); t = __builtin_amdgcn_cvt_scalef32_pk_fp4_f32(t, v[2 * q].z, v[2 * q].w, isc, 1);
                t = __builtin_amdgcn_cvt_scalef32_pk_fp4_f32(t, v[2 * q + 1].x, v[2 * q + 1].y, isc, 2); t = __builtin_amdgcn_cvt_scalef32_pk_fp4_f32(t, v[2 * q + 1].z, v[2 * q + 1].w, isc, 3); w[q] = t; }
            const float tol = am * 0.34f + 1e-30f; bool good = true;
#pragma unroll
            for (int bsel = 0; bsel < 4; ++bsel) { const f32x2_t p = (bsel == 0) ? __builtin_amdgcn_cvt_scalef32_pk_f32_fp4(w[1], isc, 0) : (bsel == 1) ? __builtin_amdgcn_cvt_scalef32_pk_f32_fp4(w[1], isc, 1) : (bsel == 2) ? __builtin_amdgcn_cvt_scalef32_pk_f32_fp4(w[1], isc, 2) : __builtin_amdgcn_cvt_scalef32_pk_f32_fp4(w[1], isc, 3);
                const f32x4 o_ = v[2 + (bsel >> 1)]; const float e0 = (bsel & 1) ? o_.z : o_.x, e1 = (bsel & 1) ? o_.w : o_.y;
                good = good && (fabsf(p.x - e0) <= tol) && (fabsf(p.y - e1) <= tol); }
            ok = __all(good);
        }
#endif
        if (!ok) {
#pragma unroll
            for (int q = 0; q < 4; ++q)
                w[q] = enc_e2m1(v[2 * q].x * sc) | (enc_e2m1(v[2 * q].y * sc) << 4) | (enc_e2m1(v[2 * q].z * sc) << 8) | (enc_e2m1(v[2 * q].w * sc) << 12)
                     | (enc_e2m1(v[2 * q + 1].x * sc) << 16) | (enc_e2m1(v[2 * q + 1].y * sc) << 20) | (enc_e2m1(v[2 * q + 1].z * sc) << 24) | (enc_e2m1(v[2 * q + 1].w * sc) << 28);
        }
        GAS unsigned* o = (GAS unsigned*)(dst + (size_t)r * 1024) + lane;
#pragma unroll
        for (int q = 0; q < 4; ++q) o[64 * q] = w[q];
        if (lane == 0) inv[r] = isc;
    }
}
__device__ __forceinline__ void cvt_rows_i4(const float* src, unsigned char* dst, float* inv, int nrows, int gw, int NGW, int lane) {
    f32x4 nx[8];
    if (gw < nrows) { const GAS f32x4* s = (const GAS f32x4*)(src + (size_t)gw * D) + 2 * lane;
#pragma unroll
        for (int q = 0; q < 4; ++q) { nx[2 * q] = __builtin_nontemporal_load(s + 128 * q); nx[2 * q + 1] = __builtin_nontemporal_load(s + 128 * q + 1); } }
    for (int r = gw; r < nrows; r += NGW) {
        f32x4 v[8]; float am = 0.f;
#pragma unroll
        for (int q = 0; q < 8; ++q) v[q] = nx[q];
        { const int rn = r + NGW; if (rn < nrows) { const GAS f32x4* s = (const GAS f32x4*)(src + (size_t)rn * D) + 2 * lane;
#pragma unroll
            for (int q = 0; q < 4; ++q) { nx[2 * q] = __builtin_nontemporal_load(s + 128 * q); nx[2 * q + 1] = __builtin_nontemporal_load(s + 128 * q + 1); } } }
#pragma unroll
        for (int q = 0; q < 8; ++q) am = fmaxf(am, fmaxf(fmaxf(fabsf(v[q].x), fabsf(v[q].y)), fmaxf(fabsf(v[q].z), fabsf(v[q].w))));
#pragma unroll
        for (int o = 1; o < 64; o <<= 1) am = fmaxf(am, __shfl_xor(am, o));
        const bool nz = am > 1e-30f; const float sc = nz ? am * (1.f / 7.f) : 1.f, isc = nz ? 7.f / am : 0.f;
        GAS unsigned* o = (GAS unsigned*)(dst + (size_t)r * 1024) + lane;
#pragma unroll
        for (int q = 0; q < 4; ++q) { unsigned w = 0u;
#pragma unroll
            for (int j = 0; j < 8; ++j) { const float x = v[2 * q + (j >> 2)][j & 3]; const unsigned bits = __builtin_bit_cast(unsigned, __builtin_fmaf(x, isc, 12582912.f));
                w |= (bits & 15u) << (4 * j); }
            o[64 * q] = w; }
        if (lane == 0) inv[r] = sc;
    }
}
__device__ __forceinline__ void peer_tables_rows(Frame& F, int Lt, int tab, int r0, int nrows, int gw, int NGW, int lane) {
    unsigned char* ws = ldws(F);
    const size_t row = (size_t)Lt * NE + r0;
#if U_FP4 && V_FP4
#if U_I4
    if (tab == 0) cvt_rows_i4(ldin(F, 17) + row * D, ws + WS_UT + row * 1024, (float*)(ws + WS_US) + row, nrows, gw, NGW, lane);
    else cvt_rows_fp4(ldin(F, 18) + row * D, ws + WS_VT + row * 1024, (float*)(ws + WS_VS) + row, nrows, gw, NGW, lane);
#else
    const float* src = (tab == 0 ? ldin(F, 17) : ldin(F, 18)) + row * D;
    cvt_rows_fp4(src, ws + (tab == 0 ? WS_UT : WS_VT) + row * 1024, (float*)(ws + (tab == 0 ? WS_US : WS_VS)) + row, nrows, gw, NGW, lane);
#endif
#else
    if (tab == 0) {
#if U_FP4
        cvt_rows_fp4(ldin(F, 17) + row * D, ws + WS_UT + row * 1024, (float*)(ws + WS_US) + row, nrows, gw, NGW, lane);
#else
        cvt_rows_fp6(ldin(F, 17) + row * D, ws + WS_UT + row * 1536, (float*)(ws + WS_US) + row, nrows, gw, NGW, lane);
#endif
    } else {
#if V_FP4
        cvt_rows_fp4(ldin(F, 18) + row * D, ws + WS_VT + row * 1024, (float*)(ws + WS_VS) + row, nrows, gw, NGW, lane);
#else
        cvt_rows_fp6(ldin(F, 18) + row * D, ws + WS_VT + row * 1536, (float*)(ws + WS_VS) + row, nrows, gw, NGW, lane);
#endif
    }
#endif
}
__device__ __forceinline__ void peer_tables_fill(Frame& F, int Lt, unsigned* qhead) {
    const int lane = lane_id();
    volatile LAS unsigned* slot = (volatile LAS unsigned*)(F.lds + MISC_OFF) + 17;
    for (;;) {
        __syncthreads();
        if (threadIdx.x == 0) *slot = atomicAdd(qhead, 1u);
        __syncthreads();
        const unsigned c = *slot;
        if (c >= (unsigned)(NE / 128)) break;
        peer_tables_rows(F, Lt, FILL_TAB, (int)c * 128, 128, F.wave, NWAVES, lane);
    }
}
__device__ __forceinline__ void p0_prologue(Frame& F) {
    const int lane = lane_id();
    unsigned char* ws = ldws(F);
    LAS float* scr = (LAS float*)(F.lds + RING_OFF + F.wave * 16384);
    const int gw = F.vcu * NWAVES + F.wave, NGW = F.G * NWAVES;
    constexpr int I_A = (D / 64) * (A_QKV / 32), I_B = (D / 64) * (B_QKV / 32), I_O = (D / 64) * (D / 32);
    constexpr int NITEMS = 2 * I_A + 2 * I_B + 4 * I_O;
    for (int rp = 0; rp < ((P0_RPT & 2) ? 2 : 1); ++rp)
    for (int it = gw; it < NITEMS; it += NGW) {
        int r = it;
        if (r < 2 * I_A) { const int j = r / I_A; p0_transpose_item(ldin(F, 1) + (size_t)j * D * A_QKV, D, A_QKV, (bf16*)(ws + WS_WQKVA) + (size_t)j * A_QKV * D, scr, r % I_A, lane); continue; } r -= 2 * I_A;
        if (r < 2 * I_B) { const int j = r / I_B; p0_transpose_item(ldin(F, 4) + (size_t)j * D * B_QKV, D, B_QKV, (bf16*)(ws + WS_WQKVB) + (size_t)j * B_QKV * D, scr, r % I_B, lane); continue; } r -= 2 * I_B;
        { const int L = r / I_O, j = L >> 1; const float* W = ((L & 1) ? ldin(F, 10) : ldin(F, 3)) + (size_t)j * D * D; p0_transpose_item(W, D, D, (bf16*)(ws + WS_WO) + (size_t)L * D * D, scr, r % I_O, lane); }
    }
    for (int R = gw; R < DEPTH * 2048; R += NGW) {
        const int hc = (R >> 7) & 15; const float* src = ldin(F, 16) + (size_t)R * 128;
        GAS v4u* drow = (GAS v4u*)((bf16*)(ws + WS_ABLK) + (size_t)R * 2048);
#pragma unroll
        for (int j = 0; j < 4; ++j) { const int p = lane + 64 * j; v4u o = {0u, 0u, 0u, 0u};
            if ((p >> 4) == hc) { const f32x4 a = *(const GAS f32x4*)(src + (p & 15) * 8), b = *(const GAS f32x4*)(src + (p & 15) * 8 + 4); o.x = pkbf(a.x, a.y); o.y = pkbf(a.z, a.w); o.z = pkbf(b.x, b.y); o.w = pkbf(b.z, b.w); }
            drow[p] = o; }
    }
    const size_t gt = (size_t)gw * 64 + lane, GT = (size_t)NGW * 64;
    cvt_stream(ldin(F, 15), (bf16*)(ws + WS_WQB), (size_t)DEPTH * D * 2048 / 8, gt, GT);
    cvt_stream(ldin(F, 0), (bf16*)(ws + WS_XB), (size_t)T * D / 8, gt, GT);
    for (int rp = 0; rp < ((P0_RPT & 1) ? 2 : 1); ++rp)
    for (int Lt = 0; Lt < DEPTH; ++Lt) {
        if (!(TABLE_FILL && (Lt & 1) && FILL_TAB == 0)) peer_tables_rows(F, Lt, 0, 0, NE, gw, NGW, lane);
        if (!(TABLE_FILL && (Lt & 1) && FILL_TAB == 1)) peer_tables_rows(F, Lt, 1, 0, NE, gw, NGW, lane);
    }
}


__device__ __forceinline__ void p1_simple(Frame& F) {
    const int lane = lane_id(); unsigned char* ws = ldws(F);
    const int gw = F.vcu * NWAVES + F.wave, NGW = F.G * NWAVES;
    const float* sk = ldin(F, 16); const float* wq = ldin(F, 15); bf16* weff = (bf16*)(ws + WS_WEFF);
    for (int it = gw; it < DEPTH * 2048 * 32; it += NGW) {
        const int R = it >> 5, ib = it & 31, L = R >> 11, hc = (R >> 7) & 15, i = ib * 64 + lane;
        const GAS f32x4* s4 = (const GAS f32x4*)(sk + (size_t)R * 128);
        const GAS f32x4* w4 = (const GAS f32x4*)(wq + ((size_t)L * 2048 + i) * 2048 + hc * 128);
        float acc = 0.f;
#pragma unroll 8
        for (int d = 0; d < 32; ++d) { const f32x4 a = s4[d], b = w4[d]; acc += a.x * b.x + a.y * b.y + a.z * b.z + a.w * b.w; }
        const unsigned pk = pkbf(acc, 0.f);
        *(GAS unsigned short*)(weff + (size_t)R * 2048 + i) = (unsigned short)(pk & 0xffffu);
    }
}

__device__ __forceinline__ void p1b_vectors(Frame& F) {
    const int lane = lane_id(); unsigned char* ws = ldws(F);
    const int gw = F.vcu * NWAVES + F.wave, NGW = F.G * NWAVES;
    const float* g1 = ldin(F, 11); const float* b1 = ldin(F, 12);
    for (int it = gw; it < DEPTH * 2048; it += NGW) { const int L = it >> 11;
        const GAS v4u* wr = (const GAS v4u*)((const bf16*)(ws + WS_WEFF) + (size_t)it * 2048);
        float c = 0.f, b = 0.f;
#pragma unroll
        for (int j = 0; j < 4; ++j) { const v4u w = wr[lane + 64 * j]; const GAS f32x4* gp = (const GAS f32x4*)(g1 + L * D + 8 * (lane + 64 * j)); const GAS f32x4* bp = (const GAS f32x4*)(b1 + L * D + 8 * (lane + 64 * j));
            const f32x4 ga = gp[0], gb = gp[1], ba = bp[0], bb = bp[1];
            const float w0 = bf_lo(w.x), w1 = bf_hi(w.x), w2 = bf_lo(w.y), w3 = bf_hi(w.y), w4 = bf_lo(w.z), w5 = bf_hi(w.z), w6 = bf_lo(w.w), w7 = bf_hi(w.w);
            c += (w0 * ga.x + w1 * ga.y) + (w2 * ga.z + w3 * ga.w) + (w4 * gb.x + w5 * gb.y) + (w6 * gb.z + w7 * gb.w);
            b += (w0 * ba.x + w1 * ba.y) + (w2 * ba.z + w3 * ba.w) + (w4 * bb.x + w5 * bb.y) + (w6 * bb.z + w7 * bb.w); }
        c = wave_sum(c); b = wave_sum(b);
        if (lane == 0) { ((float*)(ws + WS_CSW))[it] = c; ((float*)(ws + WS_CSW))[DEPTH * 2048 + it] = b; }
    }
}

__device__ __forceinline__ void ln_phase(Frame& F, const float* y, const float* g, const float* b, float* xf, bf16* xb) {
    const int lane = lane_id();
    const int gw = F.vcu * NWAVES + F.wave, NGW = F.G * NWAVES;
    for (int m = gw; m < T; m += NGW) {
        const GAS f32x4* yr = (const GAS f32x4*)(y + (size_t)m * D) + lane;
        f32x4 v[8]; float s = 0.f;
#pragma unroll
        for (int j = 0; j < 8; ++j) { v[j] = yr[64 * j]; s += (v[j].x + v[j].y) + (v[j].z + v[j].w); }
        const float mean = wave_sum(s) * (1.f / D); float s2 = 0.f;
#pragma unroll
        for (int j = 0; j < 8; ++j) { v[j] = v[j] - mean; s2 += (v[j].x * v[j].x + v[j].y * v[j].y) + (v[j].z * v[j].z + v[j].w * v[j].w); }
        const float rstd = 1.f / sqrtf(wave_sum(s2) * (1.f / D) + LN_EPS);
        GAS f32x4* of = (GAS f32x4*)(xf + (size_t)m * D) + lane; GAS v2u* ob = (GAS v2u*)(xb + (size_t)m * D) + lane;
#pragma unroll
        for (int j = 0; j < 8; ++j) { const f32x4 gg = ((const GAS f32x4*)g)[lane + 64 * j], bb = ((const GAS f32x4*)b)[lane + 64 * j];
            const f32x4 o = v[j] * rstd * gg + bb; of[64 * j] = o; v2u w; w.x = pkbf(o.x, o.y); w.y = pkbf(o.z, o.w); ob[64 * j] = w; }
    }
}

__device__ __forceinline__ int crow(int r, int hi) { return (r & 3) + 8 * (r >> 2) + 4 * hi; }
__device__ __forceinline__ s16x4 vtr(const LAS unsigned char* p) { return __builtin_bit_cast(s16x4, __builtin_amdgcn_ds_read_tr16_b64_v4i16((LAS s16x4*)p)); }
__device__ __forceinline__ bf16x8 cat8(s16x4 a, s16x4 b) { return __builtin_shufflevector(a, b, 0, 1, 2, 3, 4, 5, 6, 7); }
__device__ __forceinline__ float xhalf(float v) { return __shfl_xor(v, 32); }
__device__ __forceinline__ float xhalf_max(float v) { float a = v, b = v; asm volatile("s_nop 1\n\tv_permlane32_swap_b32 %0, %1\n\ts_nop 1" : "+v"(a), "+v"(b)); return fmaxf(a, b); }
__device__ __forceinline__ float xhalf_sum(float v) { float a = v, b = v; asm volatile("s_nop 1\n\tv_permlane32_swap_b32 %0, %1\n\ts_nop 1" : "+v"(a), "+v"(b)); return a + b; }

__device__ __forceinline__ void swa_unit(Frame& F, const bf16* qkv, bf16* ob, const float* sinks, int nb, int g) {
    LAS unsigned char* lds = F.lds + RING_OFF;
    const int lane_ = lane_id();
    const int lane = lane_, w = F.wave, hh = lane >> 5, n = lane & 31;
    __syncthreads();
#pragma unroll
    for (int i = 0; i < 4; ++i) {
        const int P = w + 8 * i;
        { const int key = 8 * P + (lane & 7), ch = lane >> 3, tok = (nb - 1) * 128 + key; v4u v = {0u, 0u, 0u, 0u};
          if (tok >= 0) v = *(const GAS v4u*)(qkv + (size_t)tok * A_QKV + 2048 + g * 64 + ch * 8);
          *(LAS v4u*)(lds + ch * 4096 + key * 16) = v; }
        { const int key = 8 * P + (lane >> 3), ch = lane & 7, tok = (nb - 1) * 128 + key; v4u v = {0u, 0u, 0u, 0u};
          if (tok >= 0) v = *(const GAS v4u*)(qkv + (size_t)tok * A_QKV + 2304 + g * 64 + ch * 8);
          *(LAS v4u*)(lds + 32768 + (ch >> 2) * 16384 + key * 64 + (ch & 3) * 16) = v; }
    }
    __syncthreads();
    const int hq = 8 * g + w;
    const float slope2 = exp2f(-0.25f * (float)(hq + 1)) * LOG2E;
    const float sink2 = sinks[hq] * LOG2E;
    const int G16 = lane >> 4, vq = (lane & 15) >> 2, vp = lane & 3;
    for (int qs = 0; qs < 4; ++qs) {
        const int qi = 32 * qs + n; const size_t tok = (size_t)nb * 128 + qi;
        bf16x8 qf[4];
#pragma unroll
        for (int s = 0; s < 4; ++s) qf[s] = *(const GAS bf16x8*)(qkv + tok * A_QKV + hq * 64 + 16 * s + 8 * hh);
        f32x16 t[5];
#pragma unroll
        for (int i = 0; i < 5; ++i) {
#pragma unroll
            for (int r = 0; r < 16; ++r) t[i][r] = 0.f;
#pragma unroll
            for (int s = 0; s < 4; ++s) { const bf16x8 a = *(const LAS bf16x8*)(lds + (2 * s + hh) * 4096 + (32 * (qs + i) + n) * 16); t[i] = MFMA32(a, qf[s], t[i]); }
        }
        float mx = sink2;
#pragma unroll
        for (int i = 0; i < 5; ++i)
#pragma unroll
            for (int r = 0; r < 16; ++r) { const int cr = (r & 3) + 8 * (r >> 2); const int dist = (128 + qi - 32 * (qs + i) - 4 * hh) - cr;
                const bool valid = (dist >= 0) && (dist < 128) && (nb > 0 || dist <= qi);
                const float s2 = valid ? (t[i][r] - slope2 * (float)dist) : NEGBIG; t[i][r] = s2; mx = fmaxf(mx, s2); }
        mx = xhalf_max(mx);
        float sum = 0.f;
#pragma unroll
        for (int i = 0; i < 5; ++i)
#pragma unroll
            for (int r = 0; r < 16; ++r) { const float p = __builtin_amdgcn_exp2f(t[i][r] - mx); t[i][r] = p; sum += p; }
        sum = xhalf_sum(sum); sum += __builtin_amdgcn_exp2f(sink2 - mx);
        const float inv = 1.f / sum;
        f32x16 o[2];
#pragma unroll
        for (int db = 0; db < 2; ++db)
#pragma unroll
            for (int r = 0; r < 16; ++r) o[db][r] = 0.f;
#pragma unroll
        for (int i = 0; i < 5; ++i)
#pragma unroll
            for (int ks = 0; ks < 2; ++ks) {
                bf16x8 pf; { v4u u; u.x = pkbf(t[i][8 * ks + 0], t[i][8 * ks + 1]); u.y = pkbf(t[i][8 * ks + 2], t[i][8 * ks + 3]); u.z = pkbf(t[i][8 * ks + 4], t[i][8 * ks + 5]); u.w = pkbf(t[i][8 * ks + 6], t[i][8 * ks + 7]); pf = __builtin_bit_cast(bf16x8, u); }
                const int key0 = 32 * (qs + i) + 16 * ks + 4 * hh + vq;
#pragma unroll
                for (int db = 0; db < 2; ++db) { const LAS unsigned char* vb = lds + 32768 + db * 16384 + key0 * 64 + (16 * (G16 & 1) + 4 * vp) * 2;
                    const bf16x8 a = cat8(vtr(vb), vtr(vb + 8 * 64)); o[db] = MFMA32(a, pf, o[db]); }
            }
        bf16* orow = ob + tok * D + hq * 64;
#pragma unroll
        for (int db = 0; db < 2; ++db)
#pragma unroll
            for (int r4 = 0; r4 < 4; ++r4) { v2u u; u.x = pkbf(o[db][4 * r4] * inv, o[db][4 * r4 + 1] * inv); u.y = pkbf(o[db][4 * r4 + 2] * inv, o[db][4 * r4 + 3] * inv);
                *(GAS v2u*)(orow + 32 * db + 8 * r4 + 4 * hh) = u; }
    }
}

constexpr int DA_STAGE = 24576, DA_NS = 4;
constexpr float DA_THR = 8.f;
#define DA_WAIT_BAR(N) asm volatile("s_waitcnt vmcnt(" #N ")\n\ts_barrier" ::: "memory")
__device__ __forceinline__ void da_issue(const bf16* kg, const bf16* vg0, const bf16* vg1, int kt, LAS unsigned char* st, int w) {
    const size_t ro = (size_t)kt * 64 * B_QKV;
    __builtin_amdgcn_global_load_lds((const unsigned*)(kg + ro), (LAS unsigned*)(st + w * 1024), 16, 0, 0);
    __builtin_amdgcn_global_load_lds((const unsigned*)(vg0 + ro), (LAS unsigned*)(st + 8192 + (2 * w) * 1024), 16, 0, 0);
    __builtin_amdgcn_global_load_lds((const unsigned*)(vg1 + ro), (LAS unsigned*)(st + 8192 + (2 * w + 1) * 1024), 16, 0, 0);
}
template <int OFF> __device__ __forceinline__ v2u ds_tr(unsigned addr) { v2u r; asm volatile("ds_read_b64_tr_b16 %0, %1 offset:%2" : "=v"(r) : "v"(addr), "n"(OFF)); return r; }
#define DA_FOFF(j) ((((j) & 3) * 4096) + (((j) >> 2) * 1024))
#define DA_RD(j, lo, hi) lo = ds_tr<DA_FOFF(j)>(sva); hi = ds_tr<DA_FOFF(j) + 512>(sva)
#define DA_MM(j, lo, hi, N) asm volatile("s_waitcnt lgkmcnt(" #N ")" : "+v"(lo), "+v"(hi)); o[(j) & 3] = MFMA32(__builtin_bit_cast(bf16x8, __builtin_shufflevector(lo, hi, 0, 1, 2, 3)), pf[(j) >> 2], o[(j) & 3])
__device__ __forceinline__ void da_pv(f32x16 (&o)[4], const bf16x8 (&pf)[4], const LAS unsigned char* sv) {
    const unsigned sva = (unsigned)(size_t)sv;
    v2u al, ah, bl, bh;
    DA_RD(0, al, ah); DA_RD(1, bl, bh);
    DA_MM(0, al, ah, 2);  DA_RD(2, al, ah);   DA_MM(1, bl, bh, 2);  DA_RD(3, bl, bh);
    DA_MM(2, al, ah, 2);  DA_RD(4, al, ah);   DA_MM(3, bl, bh, 2);  DA_RD(5, bl, bh);
    DA_MM(4, al, ah, 2);  DA_RD(6, al, ah);   DA_MM(5, bl, bh, 2);  DA_RD(7, bl, bh);
    DA_MM(6, al, ah, 2);  DA_RD(8, al, ah);   DA_MM(7, bl, bh, 2);  DA_RD(9, bl, bh);
    DA_MM(8, al, ah, 2);  DA_RD(10, al, ah);  DA_MM(9, bl, bh, 2);  DA_RD(11, bl, bh);
    DA_MM(10, al, ah, 2); DA_RD(12, al, ah);  DA_MM(11, bl, bh, 2); DA_RD(13, bl, bh);
    DA_MM(12, al, ah, 2); DA_RD(14, al, ah);  DA_MM(13, bl, bh, 2); DA_RD(15, bl, bh);
    DA_MM(14, al, ah, 2); DA_MM(15, bl, bh, 0);
}

__device__ __forceinline__ void da_norms(Frame& F, const bf16* qkv, unsigned* bnd  ) {
    const int lane = lane_id(); const int gw = F.vcu * NWAVES + F.wave, NGW = F.G * NWAVES;
    float mq[4] = {0.f, 0.f, 0.f, 0.f}, mk[4] = {0.f, 0.f, 0.f, 0.f};
    for (int t = gw; t < T; t += NGW) {
        v4u qa[4], kb4[4];
#pragma unroll
        for (int j = 0; j < 4; ++j) { qa[j] = *(const GAS v4u*)(qkv + (size_t)t * B_QKV + 512 * j + 8 * lane); kb4[j] = *(const GAS v4u*)(qkv + (size_t)t * B_QKV + 2048 + 512 * j + 8 * lane); }
#pragma unroll
        for (int j = 0; j < 4; ++j) {
            const v4u a = qa[j], b = kb4[j];
            float sa = 0.f, sb = 0.f;
#pragma unroll
            for (int e = 0; e < 4; ++e) { const float x0 = bf_lo(a[e]), x1 = bf_hi(a[e]), y0 = bf_lo(b[e]), y1 = bf_hi(b[e]); sa += x0 * x0 + x1 * x1; sb += y0 * y0 + y1 * y1; }
            sa += xor1f(sa); sa += xor2f(sa); sa += xor4f(sa); sb += xor1f(sb); sb += xor2f(sb); sb += xor4f(sb);
            mq[j] = fmaxf(mq[j], sa); mk[j] = fmaxf(mk[j], sb);
        }
    }
    LAS unsigned* red = (LAS unsigned*)(F.lds + RING_OFF + 99 * 1024);
    if (threadIdx.x < 32) red[threadIdx.x] = 0u;
    __syncthreads();
    if ((lane & 7) == 0) {
#pragma unroll
        for (int j = 0; j < 4; ++j) { const int hd = (8 * j + (lane >> 3)) >> 1; __hip_atomic_fetch_max(red + hd, __builtin_bit_cast(unsigned, mq[j]), __ATOMIC_RELAXED, __HIP_MEMORY_SCOPE_WORKGROUP); __hip_atomic_fetch_max(red + 16 + hd, __builtin_bit_cast(unsigned, mk[j]), __ATOMIC_RELAXED, __HIP_MEMORY_SCOPE_WORKGROUP); }
    }
    __syncthreads();
    if (threadIdx.x < 32) atomicMax(bnd + threadIdx.x, red[threadIdx.x]);
}
__device__ __forceinline__ void dattn_unit(Frame& F, const bf16* qkv, bf16* ob, float* stash, const float* subg, float lam, float outscale, int h, int qb, int kt_lo, int kt_hi, int part, float* pO, float* pS) {
    LAS unsigned char* lds = F.lds + RING_OFF;
    const int lane_ = lane_id();
    const int lane = lane_, w = F.wave, hh = lane >> 5, n = lane & 31;
    const int q0 = 256 * qb, q0w = q0 + 32 * w;
    const float slope2 = exp2f(-0.5f * (float)(h + 1)) * LOG2E;
    const int G16 = lane >> 4, vq = (lane & 15) >> 2, vp = lane & 3;
    const int nkt = kt_hi - kt_lo;
    const int ktw = (q0w + 31) >> 6;
    f32x16 br;
#pragma unroll
    for (int r = 0; r < 16; ++r) br[r] = slope2 * (float)crow(r, hh);
    float* mystash = stash + (size_t)(w * 64 + lane) * 64;
    int kad[4];
#pragma unroll
    for (int s = 0; s < 4; ++s) kad[s] = n * 128 + (((2 * s + hh) ^ ((n >> 1) & 7)) * 16);
    const int vad = 8192 + (4 * hh + vq) * 64 + (16 * (G16 & 1) + 4 * vp) * 2;
#pragma unroll 1
    for (int c = 0; c < 2; ++c) {
        const bf16* kg; const bf16* vg0; const bf16* vg1;
        { const int key = 8 * w + (lane >> 3), ch = (lane & 7) ^ ((key >> 1) & 7); kg = qkv + (size_t)key * B_QKV + 2048 + h * 128 + c * 64 + ch * 8; }
        { const int j0 = 2 * w, j1 = 2 * w + 1; const int k0_ = 16 * (j0 & 3) + (lane >> 2), k1_ = 16 * (j1 & 3) + (lane >> 2);
          vg0 = qkv + (size_t)k0_ * B_QKV + 4096 + h * 128 + (j0 >> 2) * 32 + (lane & 3) * 8; vg1 = qkv + (size_t)k1_ * B_QKV + 4096 + h * 128 + (j1 >> 2) * 32 + (lane & 3) * 8; }
        bf16x8 qf[4];
#pragma unroll
        for (int s = 0; s < 4; ++s) qf[s] = *(const GAS bf16x8*)(qkv + (size_t)(q0w + n) * B_QKV + h * 128 + c * 64 + 16 * s + 8 * hh);
        f32x16 o[4];
#pragma unroll
        for (int db = 0; db < 4; ++db)
#pragma unroll
            for (int r = 0; r < 16; ++r) o[db][r] = 0.f;
        float mref = NEGBIG, lsum = 0.f;
        asm volatile("s_waitcnt lgkmcnt(0)\n\ts_barrier" ::: "memory");
        da_issue(kg, vg0, vg1, kt_lo + nkt - 1, lds, w);
        da_issue(kg, vg0, vg1, nkt >= 2 ? kt_lo + nkt - 2 : kt_lo, lds + DA_STAGE, w);
        asm volatile("s_waitcnt vmcnt(6)" ::: "memory");
        const bool late = (w >= 4);
        bf16x8 pfs[4]; bool have = false;
#pragma unroll
        for (int ks = 0; ks < 4; ++ks) pfs[ks] = (bf16x8){0, 0, 0, 0, 0, 0, 0, 0};
#pragma unroll 1
        for (int it = 0; it <= nkt; ++it) {
            const int kt = kt_lo + nkt - 1 - it;
            const int sti = (it % DA_NS) * DA_STAGE;
            DA_WAIT_BAR(3);
            { const int ktn = kt - 2; da_issue(kg, vg0, vg1, ktn >= kt_lo ? ktn : kt_lo, lds + ((it + 2) % DA_NS) * DA_STAGE, w); }
            if (late && have) {
                da_pv(o, pfs, lds + ((it + DA_NS - 1) % DA_NS) * DA_STAGE + vad);
                have = false;
            }
            if (kt >= kt_lo && kt <= ktw) {
                const LAS unsigned char* st = lds + sti;
                f32x16 t0 = br, t1 = br;
                { bf16x8 kf[8];
#pragma unroll
                  for (int s = 0; s < 4; ++s) { kf[2 * s] = *(const LAS bf16x8*)(st + kad[s]); kf[2 * s + 1] = *(const LAS bf16x8*)(st + kad[s] + 4096); }
                  __builtin_amdgcn_sched_barrier(0);
#pragma unroll
                  for (int s = 0; s < 4; ++s) { t0 = MFMA32(kf[2 * s], qf[s], t0); t1 = MFMA32(kf[2 * s + 1], qf[s], t1); } }
                const float ct0 = slope2 * (float)(64 * kt - q0w), ct1 = ct0 + 32.f * slope2;
                if (64 * kt + 63 > q0w) {
                    const int dq4 = q0w + n - 64 * kt - 4 * hh;
#pragma unroll
                    for (int r = 0; r < 16; ++r) { const int cr = (r & 3) + 8 * (r >> 2); t0[r] = (cr <= dq4) ? t0[r] : NEGBIG; t1[r] = (cr + 32 <= dq4) ? t1[r] : NEGBIG; }
                }
                float m0 = t0[0], m1 = t1[0];
#pragma unroll
                for (int r = 1; r < 16; ++r) { m0 = fmaxf(m0, t0[r]); m1 = fmaxf(m1, t1[r]); }
                float mloc = fmaxf(m0 + ct0, m1 + ct1); mloc = xhalf_max(mloc);
                if (__any(mloc > mref + DA_THR)) {
                    const float mnew = fmaxf(mref, mloc), al = __builtin_amdgcn_exp2f(mref - mnew);
                    lsum *= al;
#pragma unroll
                    for (int db = 0; db < 4; ++db)
#pragma unroll
                        for (int r = 0; r < 16; ++r) o[db][r] *= al;
                    mref = mnew;
                }
                const float s0 = mref - ct0, s1 = mref - ct1;
#pragma unroll
                for (int r = 0; r < 16; ++r) { t0[r] = __builtin_amdgcn_exp2f(t0[r] - s0); t1[r] = __builtin_amdgcn_exp2f(t1[r] - s1); lsum += t0[r] + t1[r]; }
#pragma unroll
                for (int ks = 0; ks < 4; ++ks) { v4u u;
                    if (ks < 2) { u.x = pkbf(t0[8 * ks + 0], t0[8 * ks + 1]); u.y = pkbf(t0[8 * ks + 2], t0[8 * ks + 3]); u.z = pkbf(t0[8 * ks + 4], t0[8 * ks + 5]); u.w = pkbf(t0[8 * ks + 6], t0[8 * ks + 7]); }
                    else { const int k2 = ks - 2; u.x = pkbf(t1[8 * k2 + 0], t1[8 * k2 + 1]); u.y = pkbf(t1[8 * k2 + 2], t1[8 * k2 + 3]); u.z = pkbf(t1[8 * k2 + 4], t1[8 * k2 + 5]); u.w = pkbf(t1[8 * k2 + 6], t1[8 * k2 + 7]); }
                    pfs[ks] = __builtin_bit_cast(bf16x8, u); }
                if (!late) {
                    da_pv(o, pfs, st + vad);
                } else have = true;
            }
        }
        asm volatile("s_waitcnt vmcnt(0)" ::: "memory");
        if (part != 0) {
            float* po = pO + (size_t)c * 32768 + (size_t)(w * 64 + lane) * 64;
#pragma unroll
            for (int db = 0; db < 4; ++db) {
#pragma unroll
                for (int r4 = 0; r4 < 4; ++r4) { f32x4 v = {o[db][4 * r4], o[db][4 * r4 + 1], o[db][4 * r4 + 2], o[db][4 * r4 + 3]}; *(GAS f32x4*)(po + db * 16 + r4 * 4) = v; }
                asm volatile("" ::: "memory"); }
            float* ps = pS + (size_t)c * 1024 + (size_t)(w * 64 + lane) * 2; ps[0] = mref; ps[1] = lsum;
            continue;
        }
        lsum = xhalf_sum(lsum);
        const float inv = 1.f / lsum;
        if (c == 0) {
#pragma unroll
            for (int db = 0; db < 4; ++db) {
#pragma unroll
                for (int r4 = 0; r4 < 4; ++r4) { f32x4 v = {o[db][4 * r4] * inv, o[db][4 * r4 + 1] * inv, o[db][4 * r4 + 2] * inv, o[db][4 * r4 + 3] * inv}; asm volatile("" : "+v"(v)); *(GAS f32x4*)(mystash + db * 16 + r4 * 4) = v; }
                asm volatile("" ::: "memory"); }
        } else {
            VM_WAIT();
            float ss = 0.f;
#pragma unroll
            for (int db = 0; db < 4; ++db) {
#pragma unroll
                for (int r4 = 0; r4 < 4; ++r4) { const f32x4 a = __builtin_nontemporal_load((const GAS f32x4*)(mystash + db * 16 + r4 * 4));
#pragma unroll
                    for (int e = 0; e < 4; ++e) { const float d = a[e] - lam * (o[db][4 * r4 + e] * inv); o[db][4 * r4 + e] = d; ss += d * d; } }
                asm volatile("" : "+v"(o[db]), "+v"(ss) :: "memory"); }
            ss = xhalf_sum(ss);
            const float rn = 1.f / sqrtf(ss * (1.f / 128.f) + LN_EPS) * outscale;
            bf16* orow = ob + (size_t)(q0w + n) * D + h * 128 + 4 * hh;
            const float* gp = subg + 4 * hh;
#pragma unroll
            for (int db = 0; db < 4; ++db) {
#pragma unroll
                for (int r4 = 0; r4 < 4; ++r4) { const int d0 = 32 * db + 8 * r4; const f32x4 gg = *(const GAS f32x4*)(gp + d0);
                    v2u u; u.x = pkbf(o[db][4 * r4] * rn * gg.x, o[db][4 * r4 + 1] * rn * gg.y); u.y = pkbf(o[db][4 * r4 + 2] * rn * gg.z, o[db][4 * r4 + 3] * rn * gg.w);
                    asm volatile("" : "+v"(u)); *(GAS v2u*)(orow + d0) = u; }
                asm volatile("" ::: "memory"); }
        }
    }
}

__device__ __forceinline__ void da_combine(Frame& F, bf16* ob, const float* pO, const float* pS, const float* subg, float lam, float outscale, int h, int qb) {
    const int lane = lane_id(), w = F.wave, hh = lane >> 5, n = lane & 31;
    const int q0w = 256 * qb + 32 * w;
    const size_t lo = (size_t)(w * 64 + lane) * 64, ls = (size_t)(w * 64 + lane) * 2;
    float fa[2], fb[2], il[2];
#pragma unroll
    for (int c = 0; c < 2; ++c) { const float mA = pS[(0 * 2 + c) * 1024 + ls], lA = pS[(0 * 2 + c) * 1024 + ls + 1], mB = pS[(1 * 2 + c) * 1024 + ls], lB = pS[(1 * 2 + c) * 1024 + ls + 1];
        const float M = fmaxf(mA, mB); fa[c] = __builtin_amdgcn_exp2f(mA - M); fb[c] = __builtin_amdgcn_exp2f(mB - M); float l = lA * fa[c] + lB * fb[c]; l += xhalf(l); il[c] = 1.f / l; }
    f32x16 o[4]; float ss = 0.f;
#pragma unroll
    for (int db = 0; db < 4; ++db) {
#pragma unroll
        for (int r4 = 0; r4 < 4; ++r4) {
            const f32x4 a0 = *(const GAS f32x4*)(pO + (size_t)0 * 32768 + lo + db * 16 + r4 * 4), b0 = *(const GAS f32x4*)(pO + (size_t)2 * 32768 + lo + db * 16 + r4 * 4);
            const f32x4 a1 = *(const GAS f32x4*)(pO + (size_t)1 * 32768 + lo + db * 16 + r4 * 4), b1 = *(const GAS f32x4*)(pO + (size_t)3 * 32768 + lo + db * 16 + r4 * 4);
#pragma unroll
            for (int e = 0; e < 4; ++e) { const float o0 = (a0[e] * fa[0] + b0[e] * fb[0]) * il[0], o1 = (a1[e] * fa[1] + b1[e] * fb[1]) * il[1]; const float dd = o0 - lam * o1; o[db][4 * r4 + e] = dd; ss += dd * dd; } }
        asm volatile("" : "+v"(o[db]), "+v"(ss) :: "memory"); }
    ss = xhalf_sum(ss);
    const float rn = 1.f / sqrtf(ss * (1.f / 128.f) + LN_EPS) * outscale;
    bf16* orow = ob + (size_t)(q0w + n) * D + h * 128 + 4 * hh;
    const float* gp = subg + 4 * hh;
#pragma unroll
    for (int db = 0; db < 4; ++db) {
#pragma unroll
        for (int r4 = 0; r4 < 4; ++r4) { const int d0 = 32 * db + 8 * r4; const f32x4 gg = *(const GAS f32x4*)(gp + d0);
            v2u u; u.x = pkbf(o[db][4 * r4] * rn * gg.x, o[db][4 * r4 + 1] * rn * gg.y); u.y = pkbf(o[db][4 * r4 + 2] * rn * gg.z, o[db][4 * r4 + 3] * rn * gg.w);
            asm volatile("" : "+v"(u)); *(GAS v2u*)(orow + d0) = u; }
        asm volatile("" ::: "memory"); }
}

#define CE(a, b) do { const unsigned _hi = (a) > (b) ? (a) : (b), _lo = (a) > (b) ? (b) : (a); (a) = _hi; (b) = _lo; } while (0)
#define SORT16_DESC(v) do { CE(v[0],v[1]); CE(v[3],v[2]); CE(v[4],v[5]); CE(v[7],v[6]); CE(v[8],v[9]); CE(v[11],v[10]); CE(v[12],v[13]); CE(v[15],v[14]); CE(v[0],v[2]); CE(v[1],v[3]); CE(v[6],v[4]); CE(v[7],v[5]); CE(v[8],v[10]); CE(v[9],v[11]); CE(v[14],v[12]); CE(v[15],v[13]); CE(v[0],v[1]); CE(v[2],v[3]); CE(v[5],v[4]); CE(v[7],v[6]); CE(v[8],v[9]); CE(v[10],v[11]); CE(v[13],v[12]); CE(v[15],v[14]); CE(v[0],v[4]); CE(v[1],v[5]); CE(v[2],v[6]); CE(v[3],v[7]); CE(v[12],v[8]); CE(v[13],v[9]); CE(v[14],v[10]); CE(v[15],v[11]); CE(v[0],v[2]); CE(v[1],v[3]); CE(v[4],v[6]); CE(v[5],v[7]); CE(v[10],v[8]); CE(v[11],v[9]); CE(v[14],v[12]); CE(v[15],v[13]); CE(v[0],v[1]); CE(v[2],v[3]); CE(v[4],v[5]); CE(v[6],v[7]); CE(v[9],v[8]); CE(v[11],v[10]); CE(v[13],v[12]); CE(v[15],v[14]); CE(v[0],v[8]); CE(v[1],v[9]); CE(v[2],v[10]); CE(v[3],v[11]); CE(v[4],v[12]); CE(v[5],v[13]); CE(v[6],v[14]); CE(v[7],v[15]); CE(v[0],v[4]); CE(v[1],v[5]); CE(v[2],v[6]); CE(v[3],v[7]); CE(v[8],v[12]); CE(v[9],v[13]); CE(v[10],v[14]); CE(v[11],v[15]); CE(v[0],v[2]); CE(v[1],v[3]); CE(v[4],v[6]); CE(v[5],v[7]); CE(v[8],v[10]); CE(v[9],v[11]); CE(v[12],v[14]); CE(v[13],v[15]); CE(v[0],v[1]); CE(v[2],v[3]); CE(v[4],v[5]); CE(v[6],v[7]); CE(v[8],v[9]); CE(v[10],v[11]); CE(v[12],v[13]); CE(v[14],v[15]); } while (0)
#define MERGE16_DESC(v) do { CE(v[0],v[8]); CE(v[1],v[9]); CE(v[2],v[10]); CE(v[3],v[11]); CE(v[4],v[12]); CE(v[5],v[13]); CE(v[6],v[14]); CE(v[7],v[15]); CE(v[0],v[4]); CE(v[1],v[5]); CE(v[2],v[6]); CE(v[3],v[7]); CE(v[8],v[12]); CE(v[9],v[13]); CE(v[10],v[14]); CE(v[11],v[15]); CE(v[0],v[2]); CE(v[1],v[3]); CE(v[4],v[6]); CE(v[5],v[7]); CE(v[8],v[10]); CE(v[9],v[11]); CE(v[12],v[14]); CE(v[13],v[15]); CE(v[0],v[1]); CE(v[2],v[3]); CE(v[4],v[5]); CE(v[6],v[7]); CE(v[8],v[9]); CE(v[10],v[11]); CE(v[12],v[13]); CE(v[14],v[15]); } while (0)

__device__ __forceinline__ unsigned f2key(float f) { const unsigned u = __builtin_bit_cast(unsigned, f); return u ^ ((unsigned)((int)u >> 31) | 0x80000000u); }
__device__ __forceinline__ float key2f(unsigned k) { const unsigned m = (unsigned)((int)k >> 31); return __builtin_bit_cast(float, k ^ (0x80000000u | ~m)); }
__device__ __forceinline__ unsigned dpp_xor1(unsigned v) { return (unsigned)__builtin_amdgcn_mov_dpp((int)v, 0xB1, 0xF, 0xF, true); }
__device__ __forceinline__ float gelu_erf(float x) { return 0.5f * x * (1.f + erff(x * 0.70710678118654752f)); }


#if (PROBE_MASK & (64 | 128))
__device__ __forceinline__ float wave_maxf(float v) {
#pragma unroll
    for (int o = 1; o < 64; o <<= 1) v = fmaxf(v, __shfl_xor(v, o));
    return v; }
__device__ __forceinline__ int wave_mini(int v) {
#pragma unroll
    for (int o = 1; o < 64; o <<= 1) { const int t = __shfl_xor(v, o); v = t < v ? t : v; }
    return v; }
__global__ void __launch_bounds__(64) peer_ref_kernel(const unsigned char* wsb, const float* in17, size_t uoff, size_t refoff, int tstride, int nblk) {
    const float* sc = (const float*)(wsb + WS_SC); const float* x1f = (const float*)(wsb + WS_XF); const float* utab = in17 + uoff; unsigned* refbase = (unsigned*)(wsb + refoff);
    __shared__ float TV[32]; __shared__ int TI[32];
    const int lane = threadIdx.x, tok = tstride * blockIdx.x;
    unsigned* RE = refbase + blockIdx.x * 128; float* RG = (float*)(refbase + (size_t)nblk * 128) + blockIdx.x * 128; float* RA = (float*)(refbase + (size_t)nblk * 256) + blockIdx.x * 128;
    for (int h = 0; h < 8; ++h) {
        for (int c = 0; c < 2; ++c) {
            const float* s = sc + (size_t)tok * 2048 + (h * 2 + c) * 128;
            float v0 = s[lane], v1 = s[lane + 64];
            for (int r = 0; r < 16; ++r) {
                const float m = wave_maxf(fmaxf(v0, v1));
                const int cand = (v0 == m) ? lane : ((v1 == m) ? lane + 64 : 999);
                const int idx = wave_mini(cand);
                if (lane == 0) { TV[c * 16 + r] = m; TI[c * 16 + r] = idx; }
                if (idx == lane) v0 = -3e38f; if (idx == lane + 64) v1 = -3e38f;
            }
        }
        __syncthreads();
        float cs[4];
        for (int q = 0; q < 4; ++q) { const int p = lane + 64 * q; cs[q] = TV[p >> 4] + TV[16 + (p & 15)]; }
        float bestv[16]; int beste[16];
        for (int r = 0; r < 16; ++r) {
            const float lm = fmaxf(fmaxf(cs[0], cs[1]), fmaxf(cs[2], cs[3]));
            const float m = wave_maxf(lm);
            int cand = 9999;
            for (int q = 3; q >= 0; --q) if (cs[q] == m) cand = lane + 64 * q;
            const int p = wave_mini(cand);
            for (int q = 0; q < 4; ++q) if (p == lane + 64 * q) cs[q] = -3e38f;
            bestv[r] = m; beste[r] = TI[p >> 4] * 128 + TI[16 + (p & 15)];
        }
        float ssum = 0.f;
        for (int r = 0; r < 16; ++r) ssum += __expf(bestv[r] - bestv[0]);
        for (int r = 0; r < 16; ++r) {
            const float g = __expf(bestv[r] - bestv[0]) / ssum;
            const float* ur = utab + (size_t)beste[r] * D; const float* xr = x1f + (size_t)tok * D;
            float a = 0.f;
            for (int d = lane; d < D; d += 64) a += ur[d] * xr[d];
            a = wave_sum(a);
            if (lane == 0) { RE[h * 16 + r] = (unsigned)beste[r]; RG[h * 16 + r] = g; RA[h * 16 + r] = a; }
        }
        __syncthreads();
    }
}
__global__ void __launch_bounds__(64) peer_cmp_kernel(const unsigned char* wsb) {
    const float* dump = (const float*)(wsb + WS_STASH); const unsigned* refbase = (const unsigned*)(wsb + WS_CTL) + 2048 + 16384; unsigned* cnt = (unsigned*)(wsb + WS_CTL) + 2048;
    const int lane = threadIdx.x, tok = 256 * blockIdx.x;
    const unsigned* RE = refbase + blockIdx.x * 128; const float* RG = (const float*)(refbase + 4096) + blockIdx.x * 128; const float* RA = (const float*)(refbase + 8192) + blockIdx.x * 128;
    const float* dmp = dump + (size_t)tok * 384;
    unsigned be = 0, bg = 0, ba = 0;
    for (int k = lane; k < 128; k += 64) { const bool same = __builtin_bit_cast(unsigned, dmp[k]) == RE[k]; be += same ? 0u : 1u; bg += (fabsf(dmp[128 + k] - RG[k]) > 2e-3f) ? 1u : 0u; ba += (same && fabsf(dmp[256 + k] - RA[k]) > 0.03f) ? 1u : 0u; }
    atomicAdd(cnt + 0, be); atomicAdd(cnt + 1, bg); atomicAdd(cnt + 2, ba); if (lane == 0) atomicAdd(cnt + 3, 1u);
}
#endif

#ifndef SOFT_FP8_DECODE
#define SOFT_FP8_DECODE 0
#endif
__device__ __forceinline__ float dec_e4m3(unsigned b) { const unsigned mag = b & 0x7fu; const float a = mag >= 8u ? __builtin_bit_cast(float, (mag + 0x3C0u) << 20) : (float)mag * 0.001953125f; return (b & 0x80u) ? -a : a; }
__device__ __forceinline__ f32x2_t dec2_e4m3(unsigned w) {
#if SOFT_FP8_DECODE
    f32x2_t r; r.x = dec_e4m3(w & 0xffu); r.y = dec_e4m3((w >> 8) & 0xffu); return r;
#else
    return __builtin_amdgcn_cvt_pk_f32_fp8((int)w, false);
#endif
}

constexpr int PEER_WAVE_LDS = 8192;
constexpr int PEER_LNV_OFF = 8 * PEER_WAVE_LDS;
#define LNV(v, q) (*(const LAS f32x4*)(F.lds + RING_OFF + PEER_LNV_OFF + (v) * 8192 + (q) * 1024 + 16 * lane))
__device__ __forceinline__ void peer_group(Frame& F, LAS unsigned char* wl, int tok0, const _Float16* sc, const bf16* x1f  , const long long* stat1, const float* l1g, const float* l1b, const unsigned char* ut, const unsigned char* vt, const float* us, const float* vs,
                                           const float* lg, const float* lb, float* xf_out, bf16* xb_out, const float hscale, unsigned* diag, const float* utab_f32, const int nstages = 3) {
    const int lane_ = lane_id();
    const int lane = lane_;
    LAS unsigned* Ebuf = (LAS unsigned*)wl; LAS float* Gbuf = (LAS float*)(wl + 2048); LAS float* Hbuf = (LAS float*)(wl + 4096); LAS unsigned char* Ibuf = wl + 6144;
    unsigned run[16];
    {
        const int tt = lane >> 4, hc = lane & 15;
        typedef _Float16 h8 __attribute__((ext_vector_type(8)));
        const GAS h8* sp = (const GAS h8*)(sc + (size_t)(tok0 + tt) * 2048 + hc * 128);
        h8 sv[16];
#pragma unroll
        for (int i = 0; i < 16; ++i) sv[i] = sp[i];
#pragma unroll
        for (int cnk = 0; cnk < 8; ++cnk) {
            unsigned ch[16];
#pragma unroll
            for (int q = 0; q < 2; ++q) { const h8 v = sv[cnk * 2 + q];
#pragma unroll
                for (int e = 0; e < 8; ++e) ch[8 * q + e] = (f2key((float)v[e]) & ~127u) | (unsigned)(127 - (cnk * 16 + 8 * q + e)); }
            SORT16_DESC(ch);
            if (cnk == 0) {
#pragma unroll
                for (int i = 0; i < 16; ++i) run[i] = ch[i];
            } else {
#pragma unroll
                for (int i = 0; i < 16; ++i) run[i] = run[i] > ch[15 - i] ? run[i] : ch[15 - i];
                MERGE16_DESC(run);
            }
        }
    }
    unsigned res[16];
    {
        const bool odd = lane & 1;
        float av[16], bv[16];
#pragma unroll
        for (int i = 0; i < 16; ++i) { const unsigned mine = run[i], oth = dpp_xor1(mine); const unsigned a = odd ? oth : mine, b = odd ? mine : oth;
            av[i] = key2f(a & ~127u); bv[i] = key2f(b & ~127u);
            Ibuf[lane * 32 + i] = (unsigned char)(127u - (a & 127u)); Ibuf[lane * 32 + 16 + i] = (unsigned char)(127u - (b & 127u)); }
        unsigned c0[16], c1[16], c2[16], c3[16];
#pragma unroll
        for (int i = 0; i < 16; ++i) { c3[i] = 0u; }
#define CAND(idx, i, j) { const unsigned kk = (f2key(av[i] + bv[j]) & ~255u) | (unsigned)(255 - ((i) * 16 + (j))); if ((idx) < 16) c0[(idx) & 15] = kk; else if ((idx) < 32) c1[(idx) & 15] = kk; else if ((idx) < 48) c2[(idx) & 15] = kk; else c3[(idx) & 15] = kk; }
CAND(0,0,0)
CAND(1,0,1)
CAND(2,0,2)
CAND(3,0,3)
CAND(4,0,4)
CAND(5,0,5)
CAND(6,0,6)
CAND(7,0,7)
CAND(8,0,8)
CAND(9,0,9)
CAND(10,0,10)
CAND(11,0,11)
CAND(12,0,12)
CAND(13,0,13)
CAND(14,0,14)
CAND(15,0,15)
CAND(16,1,0)
CAND(17,1,1)
CAND(18,1,2)
CAND(19,1,3)
CAND(20,1,4)
CAND(21,1,5)
CAND(22,1,6)
CAND(23,1,7)
CAND(24,2,0)
CAND(25,2,1)
CAND(26,2,2)
CAND(27,2,3)
CAND(28,2,4)
CAND(29,3,0)
CAND(30,3,1)
CAND(31,3,2)
CAND(32,3,3)
CAND(33,4,0)
CAND(34,4,1)
CAND(35,4,2)
CAND(36,5,0)
CAND(37,5,1)
CAND(38,6,0)
CAND(39,6,1)
CAND(40,7,0)
CAND(41,7,1)
CAND(42,8,0)
CAND(43,9,0)
CAND(44,10,0)
CAND(45,11,0)
CAND(46,12,0)
CAND(47,13,0)
CAND(48,14,0)
CAND(49,15,0)

#undef CAND
        SORT16_DESC(c0); SORT16_DESC(c1); SORT16_DESC(c2); SORT16_DESC(c3);
#pragma unroll
        for (int i = 0; i < 16; ++i) { c0[i] = c0[i] > c1[15 - i] ? c0[i] : c1[15 - i]; c2[i] = c2[i] > c3[15 - i] ? c2[i] : c3[15 - i]; }
        MERGE16_DESC(c0); MERGE16_DESC(c2);
#pragma unroll
        for (int i = 0; i < 16; ++i) res[i] = c0[i] > c2[15 - i] ? c0[i] : c2[15 - i];
        MERGE16_DESC(res);
    }
    LDS_WAIT();
    {
        const int tt = lane >> 4, hd = (lane & 15) >> 1; const bool odd = lane & 1;
        float ev[16]; float ssum = 0.f; const float vmax = key2f(res[0] & ~255u);
#pragma unroll
        for (int r = 0; r < 16; ++r) { ev[r] = __expf(key2f(res[r] & ~255u) - vmax); ssum += ev[r]; }
        const float sinv = 1.f / ssum;
#pragma unroll
        for (int r = 0; r < 16; ++r) {
            const unsigned ci = 255u - (res[r] & 255u), i = ci >> 4, j = ci & 15u;
            const unsigned ia = Ibuf[lane * 32 + i], ib = Ibuf[lane * 32 + 16 + j];
            if (((r >> 3) & 1) == (odd ? 1 : 0)) { Ebuf[tt * 128 + hd * 16 + r] = ia * 128u + ib; Gbuf[tt * 128 + hd * 16 + r] = ev[r] * sinv; }
        }
    }
    LDS_WAIT();
#if (PROBE_MASK & 128)
    {
        LAS float* TV = (LAS float*)(wl + 7168); LAS int* TI = (LAS int*)(wl + 7168 + 128);
#pragma unroll 1
        for (int tt_ = 0; tt_ < 4; ++tt_) {
#pragma unroll 1
            for (int h = 0; h < 8; ++h) {
#pragma unroll 1
                for (int c = 0; c < 2; ++c) {
                    const float* s = sc + (size_t)(tok0 + tt_) * 2048 + (h * 2 + c) * 128;
                    float v0 = s[lane], v1 = s[lane + 64];
#pragma unroll 1
                    for (int r = 0; r < 16; ++r) {
                        const float m = wave_maxf(fmaxf(v0, v1));
                        const int cand = (v0 == m) ? lane : ((v1 == m) ? lane + 64 : 999);
                        const int idx = wave_mini(cand);
                        if (lane == 0) { TV[c * 16 + r] = m; TI[c * 16 + r] = idx; }
                        if (idx == lane) v0 = -3e38f; if (idx == lane + 64) v1 = -3e38f;
                    }
                }
                LDS_WAIT();
                float cs[4];
#pragma unroll
                for (int q = 0; q < 4; ++q) { const int p = lane + 64 * q; cs[q] = TV[p >> 4] + TV[16 + (p & 15)]; }
                float bv0 = 0.f, ssum = 0.f, myv = 0.f; int mye = 0;
#pragma unroll 1
                for (int r = 0; r < 16; ++r) {
                    const float lm = fmaxf(fmaxf(cs[0], cs[1]), fmaxf(cs[2], cs[3]));
                    const float m = wave_maxf(lm);
                    int cand = 9999;
#pragma unroll
                    for (int q = 3; q >= 0; --q) if (cs[q] == m) cand = lane + 64 * q;
                    const int p = wave_mini(cand);
#pragma unroll
                    for (int q = 0; q < 4; ++q) if (p == lane + 64 * q) cs[q] = -3e38f;
                    if (r == 0) bv0 = m;
                    const float ex = __expf(m - bv0); ssum += ex;
                    if (lane == r) { myv = ex; mye = TI[p >> 4] * 128 + TI[16 + (p & 15)]; }
                }
                if (lane < 16) { Ebuf[tt_ * 128 + h * 16 + lane] = (unsigned)mye; Gbuf[tt_ * 128 + h * 16 + lane] = myv / ssum; }
                LDS_WAIT();
            }
        }
    }
    LDS_WAIT();
#endif
#if PEER_BANDS
    {
        constexpr int BSH = (PEER_BANDS == 16) ? 10 : (PEER_BANDS == 8) ? 11 : (PEER_BANDS == 32) ? 9 : 8;
        unsigned e_[4][2]; float g_[4][2];
#pragma unroll
        for (int tt = 0; tt < 4; ++tt)
#pragma unroll
            for (int j = 0; j < 2; ++j) { e_[tt][j] = Ebuf[tt * 128 + lane + 64 * j]; g_[tt][j] = Gbuf[tt * 128 + lane + 64 * j]; }
        LDS_WAIT();
#pragma unroll
        for (int tt = 0; tt < 4; ++tt) {
            const unsigned b0 = e_[tt][0] >> BSH, b1 = e_[tt][1] >> BSH; unsigned pos0 = 0u, pos1 = 0u, basep = 0u;
#pragma unroll 1
            for (unsigned b = 0; b < (unsigned)PEER_BANDS; ++b) {
                const unsigned long long m0 = __ballot(b0 == b), m1 = __ballot(b1 == b);
                const unsigned c0 = (unsigned)__popcll(m0), c1 = (unsigned)__popcll(m1);
                const unsigned r0 = __builtin_amdgcn_mbcnt_hi((unsigned)(m0 >> 32), __builtin_amdgcn_mbcnt_lo((unsigned)m0, 0u)), r1 = __builtin_amdgcn_mbcnt_hi((unsigned)(m1 >> 32), __builtin_amdgcn_mbcnt_lo((unsigned)m1, 0u));
                if (b0 == b) pos0 = basep + r0;
                if (b1 == b) pos1 = basep + c0 + r1;
                basep += c0 + c1;
            }
            Ebuf[tt * 128 + pos0] = e_[tt][0]; Gbuf[tt * 128 + pos0] = g_[tt][0]; Ebuf[tt * 128 + pos1] = e_[tt][1]; Gbuf[tt * 128 + pos1] = g_[tt][1];
        }
        LDS_WAIT();
    }
#endif
#if U_I4 && U_CHUNKED
    LAS float* USb = (LAS float*)(wl + 6144);
    {
#pragma unroll
        for (int i = 0; i < 8; ++i) { const unsigned e_ = Ebuf[lane + 64 * i]; USb[lane + 64 * i] = *(const GAS float*)((const unsigned char*)us + (e_ << 2)); }
        LDS_WAIT();
    }
#endif
    if (nstages < 2) return;
    constexpr int PFU = 16, PFV = 16;
    const unsigned lane16 = 16u * (unsigned)lane;
    const int kl = ((lane >> 5) & 1) * 8 + ((lane >> 4) & 1) * 4 + ((lane >> 3) & 1) * 2 + ((lane >> 2) & 1);
#if U_I4 && U_CHUNKED
    {
        float vsr[8];
#pragma unroll
        for (int i = 0; i < 8; ++i) { const unsigned e_ = Ebuf[lane + 64 * i]; vsr[i] = *(const GAS float*)((const unsigned char*)vs + (e_ << 2)); }
        int xh[4][4], xl[4][4]; float xs[4];
        v4u yw[4][4]; long long st_[4][2];
#pragma unroll
        for (int t = 0; t < 4; ++t) { const size_t tk = (size_t)(tok0 + t); const GAS v4u* xr = (const GAS v4u*)(x1f + tk * D + 32 * lane);
#pragma unroll
            for (int i = 0; i < 4; ++i) yw[t][i] = xr[i];
            st_[t][0] = stat1[2 * tk]; st_[t][1] = stat1[2 * tk + 1]; }
        v4u ub[16]; float usc[16];
#pragma unroll
        for (int k = 0; k < 16; ++k) { const unsigned e_ = Ebuf[k]; ub[k] = *(const GAS v4u*)(ut + ((e_ << 10) + lane16)); usc[k] = USb[k]; }
#pragma unroll
        for (int t = 0; t < 4; ++t) {
            const float s1 = (float)st_[t][0] * 2.3283064365386963e-10f, s2 = (float)st_[t][1] * 2.3283064365386963e-10f; const float mu = s1 * (1.f / D), rstd = 1.f / sqrtf(s2 * (1.f / D) - mu * mu + LN_EPS), mr = mu * rstd;
            float xv[32]; float mx = 0.f;
#pragma unroll
            for (int q = 0; q < 8; ++q) { const unsigned w0 = yw[t][q >> 1][2 * (q & 1)], w1 = yw[t][q >> 1][2 * (q & 1) + 1]; const f32x4 gq = LNV(0, q), bq = LNV(1, q);
                xv[4 * q] = rstd * bf_lo(w0) + (bq.x - mr * gq.x); xv[4 * q + 1] = rstd * bf_hi(w0) + (bq.y - mr * gq.y); xv[4 * q + 2] = rstd * bf_lo(w1) + (bq.z - mr * gq.z); xv[4 * q + 3] = rstd * bf_hi(w1) + (bq.w - mr * gq.w);
                mx = fmaxf(mx, fmaxf(fmaxf(fabsf(xv[4 * q]), fabsf(xv[4 * q + 1])), fmaxf(fabsf(xv[4 * q + 2]), fabsf(xv[4 * q + 3])))); }
            mx = wave_max_all(mx);
            const float isx = mx > 1e-30f ? 119.f / mx : 0.f; xs[t] = mx * (1.f / 119.f);
#pragma unroll
            for (int d = 0; d < 4; ++d) { unsigned h_ = 0u, l_ = 0u;
#pragma unroll
                for (int j = 0; j < 8; ++j) { const int qi = (int)__builtin_bit_cast(unsigned, __builtin_fmaf(xv[8 * d + j], isx, 12582912.f)) - 0x4B400000; const int hi = (qi + 8) >> 4, lo = qi - (hi << 4);
                    h_ |= ((unsigned)hi & 15u) << (4 * j); l_ |= ((unsigned)lo & 15u) << (4 * j); }
                xh[t][d] = (int)h_; xl[t][d] = (int)l_; }
        }
#pragma unroll 1
        for (int j = 0; j < 8; ++j) {
#pragma unroll
            for (int t = 0; t < 4; ++t) {
                const int cur = t * 128 + 16 * j;
                const int nxt = (t < 3) ? (t + 1) * 128 + 16 * j : (j < 7 ? 16 * (j + 1) : cur);
                v4u uid[4];
                f32x4 usn[4];
                { const LAS v4u* ip = (const LAS v4u*)(Ebuf + nxt); const LAS f32x4* sp_ = (const LAS f32x4*)(USb + nxt);
#pragma unroll
                  for (int i = 0; i < 4; ++i) { uid[i] = ip[i]; usn[i] = sp_[i]; } }
                float part[16];
#pragma unroll
                for (int k = 0; k < 16; ++k) {
                    { const v4u pk = ub[k]; int aH = 0, aL = 0;
#pragma unroll
                      for (int d4 = 0; d4 < 4; ++d4) { aH = __builtin_amdgcn_sdot8((int)pk[d4], xh[t][d4], aH, false); aL = __builtin_amdgcn_sdot8((int)pk[d4], xl[t][d4], aL, false); }
                      part[k] = (float)(aH * 16 + aL) * usc[k]; }
                    { const unsigned e_ = uid[k >> 2][k & 3]; ub[k] = *(const GAS v4u*)(ut + ((e_ << 10) + lane16)); usc[k] = usn[k >> 2][k & 3]; }
                }
#pragma unroll
                for (int i = 0; i < 8; ++i) part[i] = swapsum32(part[i], part[i + 8]);
#pragma unroll
                for (int i = 0; i < 4; ++i) part[i] = swapsum16(part[i], part[i + 4]);
#pragma unroll
                for (int i = 0; i < 2; ++i) { const bool up = lane & 8; const float snd = up ? part[i] : part[i + 2], kp = up ? part[i + 2] : part[i]; part[i] = kp + xor8f(snd); }
                { const bool up = lane & 4; const float snd = up ? part[0] : part[1], kp = up ? part[1] : part[0]; part[0] = kp + xor4f(snd); }
                part[0] += xor2f(part[0]); part[0] += xor1f(part[0]);
                part[0] *= xs[t];
                if ((lane & 3) == 0) Hbuf[cur + kl] = Gbuf[cur + kl] * gelu_erf(part[0]) * hscale;
            }
        }
        LDS_WAIT();
#pragma unroll
        for (int i = 0; i < 8; ++i) Gbuf[lane + 64 * i] = vsr[i];
    }
#else
    {
#if U_FP4
        v4u ub[PFU]; float usc[PFU];
#pragma unroll
        for (int j = 0; j < PFU; ++j) { const unsigned e_ = Ebuf[j]; ub[j] = *(const GAS v4u*)(ut + (size_t)e_ * 1024 + 16 * lane); usc[j] = us[e_]; }
#else
        v3u ub[PFU][2]; float usc[PFU];
#pragma unroll
        for (int j = 0; j < PFU; ++j) { const unsigned e_ = Ebuf[j]; const unsigned char* p = ut + (size_t)e_ * 1536 + 24 * lane; ub[j][0] = *(const GAS v3u*)p; ub[j][1] = *(const GAS v3u*)(p + 12); usc[j] = us[e_]; }
#endif
        f32x2_t xf2[16];
#if U_I4
        int xh[4], xl[4]; float xscale = 0.f;
#endif
#pragma unroll 1
        for (int base = 0; base < 512; base += 16) {
            if ((base & 127) == 0) { const size_t tk = (size_t)(tok0 + (base >> 7)); const GAS v4u* xr = (const GAS v4u*)(x1f + tk * D + 32 * lane);
                const float s1 = (float)stat1[2 * tk] * 2.3283064365386963e-10f, s2 = (float)stat1[2 * tk + 1] * 2.3283064365386963e-10f; const float mu = s1 * (1.f / D), rstd = 1.f / sqrtf(s2 * (1.f / D) - mu * mu + LN_EPS), mr = mu * rstd;
                v4u yw[4];
#pragma unroll
                for (int i = 0; i < 4; ++i) yw[i] = xr[i];
#pragma unroll
                for (int q = 0; q < 8; ++q) { const unsigned w0 = yw[q >> 1][2 * (q & 1)], w1 = yw[q >> 1][2 * (q & 1) + 1]; const f32x4 gq = LNV(0, q), bq = LNV(1, q);
                    xf2[2 * q] = f32x2_t{rstd * bf_lo(w0) + (bq.x - mr * gq.x), rstd * bf_hi(w0) + (bq.y - mr * gq.y)}; xf2[2 * q + 1] = f32x2_t{rstd * bf_lo(w1) + (bq.z - mr * gq.z), rstd * bf_hi(w1) + (bq.w - mr * gq.w)}; }
#if U_I4
                {
                    float mx = 0.f;
#pragma unroll
                    for (int i = 0; i < 16; ++i) mx = fmaxf(mx, fmaxf(fabsf(xf2[i].x), fabsf(xf2[i].y)));
                    mx = wave_max_all(mx);
                    const float isx = mx > 1e-30f ? 119.f / mx : 0.f; xscale = mx * (1.f / 119.f);
#pragma unroll
                    for (int d = 0; d < 4; ++d) { unsigned h_ = 0u, l_ = 0u;
#pragma unroll
                        for (int j = 0; j < 8; ++j) { const int el = 8 * d + j; const float xv = (el & 1) ? xf2[el >> 1].y : xf2[el >> 1].x; const int qi = (int)__builtin_bit_cast(unsigned, __builtin_fmaf(xv, isx, 12582912.f)) - 0x4B400000; const int hi = (qi + 8) >> 4, lo = qi - (hi << 4);
                            h_ |= ((unsigned)hi & 15u) << (4 * j); l_ |= ((unsigned)lo & 15u) << (4 * j); }
                        xh[d] = (int)h_; xl[d] = (int)l_; }
                }
#endif
            }
#if U_FP4
            v4u uid[4];
            { const LAS v4u* ip = (const LAS v4u*)(Ebuf + (base + 16 < 512 ? base + 16 : 496));
#pragma unroll
              for (int i = 0; i < 4; ++i) uid[i] = ip[i]; }
#endif
            float part[16];
#pragma unroll
            for (int k = 0; k < 16; ++k) {
                f32x2_t A0 = {0.f, 0.f}, A1 = {0.f, 0.f};
#if U_I4
                { const v4u pk = ub[k % PFU]; int aH = 0, aL = 0;
#pragma unroll
                  for (int d4 = 0; d4 < 4; ++d4) { aH = __builtin_amdgcn_sdot8((int)pk[d4], xh[d4], aH, false); aL = __builtin_amdgcn_sdot8((int)pk[d4], xl[d4], aL, false); }
                  part[k] = (float)(aH * 16 + aL) * usc[k % PFU]; (void)A0; (void)A1; }
                { const unsigned e_ = uid[k >> 2][k & 3]; ub[k % PFU] = *(const GAS v4u*)(ut + ((e_ << 10) + lane16)); usc[k % PFU] = *(const GAS float*)((const unsigned char*)us + (e_ << 2)); }
#elif U_FP4
                { const v4u pk = ub[k % PFU]; const float sc_ = usc[k % PFU];
#pragma unroll
                  for (int d4 = 0; d4 < 4; ++d4) { const f32x2_t p0 = __builtin_amdgcn_cvt_scalef32_pk_f32_fp4(pk[d4], sc_, 0), p1 = __builtin_amdgcn_cvt_scalef32_pk_f32_fp4(pk[d4], sc_, 1), p2 = __builtin_amdgcn_cvt_scalef32_pk_f32_fp4(pk[d4], sc_, 2), p3 = __builtin_amdgcn_cvt_scalef32_pk_f32_fp4(pk[d4], sc_, 3);
                      A0 = __builtin_elementwise_fma(p0, xf2[4 * d4], A0); A1 = __builtin_elementwise_fma(p1, xf2[4 * d4 + 1], A1); A0 = __builtin_elementwise_fma(p2, xf2[4 * d4 + 2], A0); A1 = __builtin_elementwise_fma(p3, xf2[4 * d4 + 3], A1); } }
                part[k] = (A0.x + A0.y) + (A1.x + A1.y);
                { const unsigned e_ = (PFU == 16) ? uid[k >> 2][k & 3] : Ebuf[(base + k + PFU) < 512 ? (base + k + PFU) : 511]; ub[k % PFU] = *(const GAS v4u*)(ut + ((e_ << 10) + lane16)); usc[k % PFU] = *(const GAS float*)((const unsigned char*)us + (e_ << 2)); }
#else
                v6u pk; pk[0] = ub[k % PFU][0][0]; pk[1] = ub[k % PFU][0][1]; pk[2] = ub[k % PFU][0][2]; pk[3] = ub[k % PFU][1][0]; pk[4] = ub[k % PFU][1][1]; pk[5] = ub[k % PFU][1][2];
                const f32x32 dv = __builtin_amdgcn_cvt_scalef32_pk32_f32_fp6(pk, usc[k % PFU]);
#pragma unroll
                for (int q = 0; q < 8; ++q) { A0 = __builtin_elementwise_fma(f32x2_t{dv[4 * q], dv[4 * q + 1]}, xf2[2 * q], A0); A1 = __builtin_elementwise_fma(f32x2_t{dv[4 * q + 2], dv[4 * q + 3]}, xf2[2 * q + 1], A1); }
                part[k] = (A0.x + A0.y) + (A1.x + A1.y);
                { int nx = base + k + PFU; nx = nx < 512 ? nx : 511; const unsigned e_ = Ebuf[nx]; const unsigned char* p = ut + (size_t)e_ * 1536 + 24 * lane; ub[k % PFU][0] = *(const GAS v3u*)p; ub[k % PFU][1] = *(const GAS v3u*)(p + 12); usc[k % PFU] = us[e_]; }
#endif
            }
#pragma unroll
            for (int i = 0; i < 8; ++i) part[i] = swapsum32(part[i], part[i + 8]);
#pragma unroll
            for (int i = 0; i < 4; ++i) part[i] = swapsum16(part[i], part[i + 4]);
#pragma unroll
            for (int i = 0; i < 2; ++i) { const bool up = lane & 8; const float snd = up ? part[i] : part[i + 2], kp = up ? part[i + 2] : part[i]; part[i] = kp + xor8f(snd); }
            { const bool up = lane & 4; const float snd = up ? part[0] : part[1], kp = up ? part[1] : part[0]; part[0] = kp + xor4f(snd); }
            part[0] += xor2f(part[0]); part[0] += xor1f(part[0]);
#if U_I4
            part[0] *= xscale;
#endif
            if ((lane & 3) == 0) Hbuf[base + kl] = Gbuf[base + kl] * gelu_erf(part[0]) * hscale;
        }
    }
#endif
    LDS_WAIT();
    if (nstages < 3) return;
    {
#if V_FP4
        v4u vb[PFV]; float vsc[PFV];
#pragma unroll
        for (int j = 0; j < PFV; ++j) { const unsigned e_ = Ebuf[j]; vb[j] = *(const GAS v4u*)(vt + (size_t)e_ * 1024 + 16 * lane); vsc[j] = (U_I4 && U_CHUNKED) ? Gbuf[j] : vs[e_]; }
#else
        v3u vb[PFV][2]; float vsc[PFV];
#pragma unroll
        for (int j = 0; j < PFV; ++j) { const unsigned e_ = Ebuf[j]; const unsigned char* p = vt + (size_t)e_ * 1536 + 24 * lane; vb[j][0] = *(const GAS v3u*)p; vb[j][1] = *(const GAS v3u*)(p + 12); vsc[j] = vs[e_]; }
#endif
        f32x2_t acc2[16];
#define acc_(i) acc2[(i) >> 1][(i) & 1]
#pragma unroll
        for (int q = 0; q < 16; ++q) acc2[q] = f32x2_t{0.f, 0.f};
        v4u yv[4]; long long sv[2];
#pragma unroll 1
        for (int base = 0; base < 512; base += PFV) {
            if ((base & 127) == 128 - 3 * PFV) { const size_t tk = (size_t)(tok0 + (base >> 7)); const GAS v4u* xr = (const GAS v4u*)(x1f + tk * D + 32 * lane);
#pragma unroll
                for (int q = 0; q < 4; ++q) yv[q] = xr[q];
                sv[0] = stat1[2 * tk]; sv[1] = stat1[2 * tk + 1]; }
#if V_FP4
            v4u vid[4]; f32x4 vsn[4];
            { const LAS v4u* ip = (const LAS v4u*)(Ebuf + (base + 16 < 512 ? base + 16 : 496)); const LAS f32x4* sp_ = (const LAS f32x4*)(Gbuf + (base + 16 < 512 ? base + 16 : 496));
#pragma unroll
              for (int i = 0; i < 4; ++i) { vid[i] = ip[i]; vsn[i] = sp_[i]; } }
#endif
            f32x4 hv[PFV / 4];
            { const LAS f32x4* hp = (const LAS f32x4*)(Hbuf + base);
#pragma unroll
              for (int i = 0; i < PFV / 4; ++i) hv[i] = hp[i]; }
#pragma unroll
            for (int k = 0; k < PFV; ++k) {
                const float hk = hv[k >> 2][k & 3]; const f32x2_t hk2 = {hk, hk};
#if V_FP4
                { const v4u pk = vb[k]; const float sc_ = vsc[k];
#pragma unroll
                  for (int d4 = 0; d4 < 4; ++d4) { const f32x2_t p0 = __builtin_amdgcn_cvt_scalef32_pk_f32_fp4(pk[d4], sc_, 0), p1 = __builtin_amdgcn_cvt_scalef32_pk_f32_fp4(pk[d4], sc_, 1), p2 = __builtin_amdgcn_cvt_scalef32_pk_f32_fp4(pk[d4], sc_, 2), p3 = __builtin_amdgcn_cvt_scalef32_pk_f32_fp4(pk[d4], sc_, 3);
                      acc2[4 * d4] = __builtin_elementwise_fma(hk2, p0, acc2[4 * d4]); acc2[4 * d4 + 1] = __builtin_elementwise_fma(hk2, p1, acc2[4 * d4 + 1]); acc2[4 * d4 + 2] = __builtin_elementwise_fma(hk2, p2, acc2[4 * d4 + 2]); acc2[4 * d4 + 3] = __builtin_elementwise_fma(hk2, p3, acc2[4 * d4 + 3]); } }
                { const unsigned e_ = (PFV == 16) ? vid[k >> 2][k & 3] : Ebuf[(base + k + PFV) < 512 ? (base + k + PFV) : 511]; vb[k] = *(const GAS v4u*)(vt + ((e_ << 10) + lane16)); vsc[k] = (U_I4 && U_CHUNKED) ? vsn[k >> 2][k & 3] : *(const GAS float*)((const unsigned char*)vs + (e_ << 2)); }
#else
                v6u pk; pk[0] = vb[k][0][0]; pk[1] = vb[k][0][1]; pk[2] = vb[k][0][2]; pk[3] = vb[k][1][0]; pk[4] = vb[k][1][1]; pk[5] = vb[k][1][2];
                const f32x32 dv = __builtin_amdgcn_cvt_scalef32_pk32_f32_fp6(pk, vsc[k]);
#pragma unroll
                for (int q = 0; q < 16; ++q) acc2[q] = __builtin_elementwise_fma(hk2, f32x2_t{dv[2 * q], dv[2 * q + 1]}, acc2[q]);
                { int nx = base + k + PFV; nx = nx < 512 ? nx : 511; const unsigned e_ = Ebuf[nx]; const unsigned char* p = vt + (size_t)e_ * 1536 + 24 * lane; vb[k][0] = *(const GAS v3u*)p; vb[k][1] = *(const GAS v3u*)(p + 12); vsc[k] = vs[e_]; }
#endif
            }
            if ((base & 127) == 128 - PFV) {
                const size_t tok = (size_t)(tok0 + (base >> 7));
                { const float s1_ = (float)sv[0] * 2.3283064365386963e-10f, s2_ = (float)sv[1] * 2.3283064365386963e-10f; const float mu_ = s1_ * (1.f / D), rs_ = 1.f / sqrtf(s2_ * (1.f / D) - mu_ * mu_ + LN_EPS), mr_ = mu_ * rs_;
#pragma unroll
                  for (int q = 0; q < 8; ++q) { const unsigned w0 = yv[q >> 1][2 * (q & 1)], w1 = yv[q >> 1][2 * (q & 1) + 1]; const f32x4 gq = LNV(0, q), bq = LNV(1, q);
                      acc_(4 * q) += ALPHA * (rs_ * bf_lo(w0) + (bq.x - mr_ * gq.x)); acc_(4 * q + 1) += ALPHA * (rs_ * bf_hi(w0) + (bq.y - mr_ * gq.y)); acc_(4 * q + 2) += ALPHA * (rs_ * bf_lo(w1) + (bq.z - mr_ * gq.z)); acc_(4 * q + 3) += ALPHA * (rs_ * bf_hi(w1) + (bq.w - mr_ * gq.w)); } }
                float s = 0.f;
#pragma unroll
                for (int q = 0; q < 32; ++q) s += acc_(q);
                const float mean = wave_sum(s) * (1.f / D); float s2 = 0.f;
#pragma unroll
                for (int q = 0; q < 32; ++q) { acc_(q) -= mean; s2 += acc_(q) * acc_(q); }
                const float rstd = 1.f / sqrtf(wave_sum(s2) * (1.f / D) + LN_EPS);
                const int col = 32 * lane;
#pragma unroll
                for (int q = 0; q < 8; q += 2) { v4u wb;
#pragma unroll
                    for (int h2 = 0; h2 < 2; ++h2) { const int qq = q + h2; const f32x4 gq = LNV(2, qq), bq = LNV(3, qq);
                        f32x4 o; o.x = acc_(4 * qq) * rstd * gq.x + bq.x; o.y = acc_(4 * qq + 1) * rstd * gq.y + bq.y; o.z = acc_(4 * qq + 2) * rstd * gq.z + bq.z; o.w = acc_(4 * qq + 3) * rstd * gq.w + bq.w;
                        if (xf_out) *(GAS f32x4*)(xf_out + tok * D + col + 4 * qq) = o; wb[2 * h2] = pkbf(o.x, o.y); wb[2 * h2 + 1] = pkbf(o.z, o.w); }
                    if (xb_out) *(GAS v4u*)(xb_out + tok * D + col + 4 * q) = wb; }
#pragma unroll
                for (int q = 0; q < 32; ++q) acc_(q) = 0.f;
            }
        }
#undef acc_
    }
}

#ifndef EN_MASK
#define EN_MASK 0x1ff
#endif
constexpr bool EN_P0 = EN_MASK & 1, EN_P1 = EN_MASK & 2, EN_QKV = EN_MASK & 4, EN_SWA = EN_MASK & 8, EN_DA = EN_MASK & 16, EN_WO = EN_MASK & 32, EN_LN = EN_MASK & 64, EN_SC = EN_MASK & 128, EN_PEER = EN_MASK & 256;

struct Args { const float* in[19]; float* out; unsigned char* ws; int ph_lo, ph_hi, li, pad; };
__global__ void __launch_bounds__(NWAVES * 64, 2) hybrid_fwd(Args args) {
    extern __shared__ __attribute__((aligned(16))) unsigned char lds[];
    Frame F;
    F.lds = (LAS unsigned char*)lds;
    F.wave = __builtin_amdgcn_readfirstlane((int)(threadIdx.x >> 6));
    F.G = gridDim.x; { const int bx = blockIdx.x; F.vcu = (F.G % 8 == 0) ? (bx % 8) * (F.G / 8) + bx / 8 : bx; }
    for (int u = threadIdx.x; u < (LDS_BYTES - LDSCTL_OFF) / 4; u += NWAVES * 64) ((LAS unsigned*)(F.lds + LDSCTL_OFF))[u] = 0u;
    __syncthreads();
    if (threadIdx.x < 19) *(LAS unsigned long long*)(F.lds + PT_OFF + 8 * threadIdx.x) = (unsigned long long)args.in[threadIdx.x];
    if (threadIdx.x == 19) *(LAS unsigned long long*)(F.lds + PT_OFF + 8 * PT_OUT) = (unsigned long long)args.out;
    if (threadIdx.x == 20) *(LAS unsigned long long*)(F.lds + PT_OFF + 8 * PT_WS) = (unsigned long long)args.ws;
    __syncthreads();
    XcdBarrier bar = xcd_barrier_post((unsigned*)(args.ws + WS_CTL) + CW_BAR + args.li * XCD_BAR_WORDS, (volatile LAS unsigned*)(F.lds + MISC_OFF) + 8);
    const int lo = args.ph_lo, hi = args.ph_hi;
#define IN(k) (lo <= (k) && (k) < hi)
#define SEAM(k) do { if ((k) + 1 < hi) xcd_barrier(bar); } while (0)
#define RPT(bit, ...) do { __VA_ARGS__; if (RPT_MASK & (bit)) { xcd_barrier(bar); __VA_ARGS__; } } while (0)

    if (EN_P0 && IN(0)) { RPT(1, p0_prologue(F)); SEAM(0); }
    if ((PROBE_MASK & 8) && IN(1)) { p1_simple(F); SEAM(1); }
    else if (EN_P1 && IN(1)) {
        unsigned char* ws = ldws(F);
        pg8::Gemm g{(const pg8::bf16_t*)(ws + WS_ABLK), (const pg8::bf16_t*)(ws + WS_WQB), DEPTH * 2048, 2048, 2048, 1};
        pg8::StackOrder S; S.init(DEPTH * 2048, 2048, F.G, (int)blockIdx.x);
        pg8::EpiBf16S E{(pg8::bf16_t*)(ws + WS_WEFF), 2048, 0, 1.f, 7};
        RPT(2, pg8::gemm_phase<pg8::EpiBf16S, pg8::StackOrder, true, true>(F.lds + RING_OFF, g, S, E, F.wave));
    }
    const Frame F0 = F; const int lo0 = lo, hi0 = hi;
#pragma unroll 1
    for (int L = 0; L < DEPTH; ++L) {
        Frame F; F.wave = opaque_u(F0.wave); F.vcu = opaque_u(F0.vcu); F.G = opaque_u(F0.G); F.lds = (LAS unsigned char*)(size_t)(unsigned)opaque_u((int)(unsigned)(size_t)F0.lds);
        const int lo = opaque_u(lo0), hi = opaque_u(hi0);
        const int pb = 2 + 6 * L, j = L >> 1; const bool isB = L & 1;
        if (EN_QKV && IN(pb + 0)) {
            unsigned char* ws = ldws(F);
            const int N = isB ? B_QKV : A_QKV;
            const pg8::bf16_t* Wt = isB ? (const pg8::bf16_t*)(ws + WS_WQKVB) + (size_t)j * B_QKV * D : (const pg8::bf16_t*)(ws + WS_WQKVA) + (size_t)j * A_QKV * D;
            pg8::Gemm g{(const pg8::bf16_t*)(ws + WS_XB), Wt, T, N, D, 0};
            pg8::StaticOrder S; S.init(T, N, F.G, (int)blockIdx.x);
            pg8::EpiBf16S E{(pg8::bf16_t*)(ws + WS_QKV), N, 2048, C2, 0x7fffffff};
            RPT(2, pg8::gemm_phase<pg8::EpiBf16S, pg8::StaticOrder, true, true>(F.lds + RING_OFF, g, S, E, F.wave));
            if (TABLE_FILL && !isB) peer_tables_fill(F, L + 1, (unsigned*)(ws + WS_CTL) + CW_CVT + 64 * j);
            SEAM(pb + 0);
        }
        if (IN(pb + 1)) {
            unsigned char* ws = ldws(F);
            if (EN_SWA && !isB) {
                if (L == 0) p1b_vectors(F);
                const float* sinks = ldin(F, 2) + j * 32;
                RPT(4, for (int u = F.vcu; u < 256; u += F.G) swa_unit(F, (const bf16*)(ws + WS_QKV), (bf16*)(ws + WS_OB), sinks, u >> 2, u & 3));
            } else if (EN_DA && isB) {
                const float li = (L == 1) ? 0.35550906759096926f : 0.5560582041556405f;
                const int ln = lane_id();
                float d1 = ldin(F, 5)[j * 64 + ln] * ldin(F, 6)[j * 64 + ln], d2 = ldin(F, 7)[j * 64 + ln] * ldin(F, 8)[j * 64 + ln];
                d1 = wave_sum(d1); d2 = wave_sum(d2);
                const float lam = expf(d1) - expf(d2) + li;
                float* stash = (float*)(ws + WS_STASH) + (size_t)blockIdx.x * (256 * 128);
                const float* subg = ldin(F, 9) + j * 128;
                unsigned* bnd = (unsigned*)(ws + WS_CTL) + CW_DA + 64 * j;
                da_norms(F, (const bf16*)(ws + WS_QKV), bnd);
                xcd_barrier(bar);
                LAS unsigned* TBL = (LAS unsigned*)(F.lds + RING_OFF + 100 * 1024);
                LAS unsigned* TB2 = TBL + 1024;
                LAS unsigned* SPL = TBL + 2048;
                LAS unsigned* HST = TBL + 2048 + 192;
                for (int i = threadIdx.x; i < 129; i += NWAVES * 64) HST[i] = 0u;
                __syncthreads();
                if (F.wave == 0) {
                    const int ln = lane_id();
                    unsigned ka[8], km[8], kb[8]; int spl[8]; int nspl_l = 0;
#pragma unroll
                    for (int q = 0; q < 8; ++q) { const int idx = 8 * ln + q, qb = 31 - (idx >> 4), h = 15 - (idx & 15);
                        const float qn2 = __builtin_bit_cast(float, __hip_atomic_load(bnd + h, __ATOMIC_RELAXED, __HIP_MEMORY_SCOPE_AGENT)), kn2 = __builtin_bit_cast(float, __hip_atomic_load(bnd + 16 + h, __ATOMIC_RELAXED, __HIP_MEMORY_SCOPE_AGENT));
                        const float B = sqrtf(qn2 * kn2) * 1.001f, slope2 = exp2f(-0.5f * (float)(h + 1)) * LOG2E, dsk = (160.f + 2.f * B) / slope2;
                        int kt_lo = 0; if (dsk < 16384.f) { const int first = 256 * qb - ((int)dsk + 2); kt_lo = first > 0 ? (first >> 6) : 0; }
                        const int khi = 4 * qb + 4, cost = khi - kt_lo;
                        ka[q] = (unsigned)kt_lo; kb[q] = (unsigned)khi; km[q] = (unsigned)(kt_lo + (cost >> 1)); spl[q] = cost > DA_CMAX ? 1 : 0; nspl_l += spl[q]; }
                    int ospl = nspl_l;
#pragma unroll
                    for (int o = 1; o < 64; o <<= 1) { const int b = __shfl_up(ospl, o); if (ln >= o) ospl += b; }
                    const int tot_spl = __shfl(ospl, 63);
                    int pp = ospl - nspl_l;
#pragma unroll
                    for (int q = 0; q < 8; ++q) { if (spl[q]) { if (pp >= 128) spl[q] = 0; ++pp; } }
                    pp = ospl - nspl_l;
#pragma unroll
                    for (int q = 0; q < 8; ++q) { if (spl[q]) { __hip_atomic_fetch_add(HST + (kb[q] - km[q]), 1u, __ATOMIC_RELAXED, __HIP_MEMORY_SCOPE_WORKGROUP); __hip_atomic_fetch_add(HST + (km[q] - ka[q]), 1u, __ATOMIC_RELAXED, __HIP_MEMORY_SCOPE_WORKGROUP); } else __hip_atomic_fetch_add(HST + (kb[q] - ka[q]), 1u, __ATOMIC_RELAXED, __HIP_MEMORY_SCOPE_WORKGROUP); }
                    LDS_WAIT();
                    { const unsigned c_hi = HST[128 - 2 * ln], c_lo = HST[127 - 2 * ln]; unsigned run = c_hi + c_lo;
#pragma unroll
                      for (int o = 1; o < 64; o <<= 1) { const unsigned b = __shfl_up(run, o); if (ln >= o) run += b; }
                      const unsigned ex = run - (c_hi + c_lo); LDS_WAIT(); HST[128 - 2 * ln] = ex; HST[127 - 2 * ln] = ex + c_hi; if (ln == 63) SPL[128] = run; }
                    LDS_WAIT();
#pragma unroll
                    for (int q = 0; q < 8; ++q) { const unsigned idx = (unsigned)(8 * ln + q);
                        if (spl[q]) { const unsigned p1 = __hip_atomic_fetch_add(HST + (kb[q] - km[q]), 1u, __ATOMIC_RELAXED, __HIP_MEMORY_SCOPE_WORKGROUP), p2 = __hip_atomic_fetch_add(HST + (km[q] - ka[q]), 1u, __ATOMIC_RELAXED, __HIP_MEMORY_SCOPE_WORKGROUP);
                            TBL[p1] = idx | (1u << 9) | (km[q] << 11) | (kb[q] << 19); TB2[p1] = (unsigned)pp; TBL[p2] = idx | (2u << 9) | (ka[q] << 11) | (km[q] << 19); TB2[p2] = (unsigned)pp; SPL[pp] = idx; ++pp; }
                        else { const unsigned p1 = __hip_atomic_fetch_add(HST + (kb[q] - ka[q]), 1u, __ATOMIC_RELAXED, __HIP_MEMORY_SCOPE_WORKGROUP); TBL[p1] = idx | (ka[q] << 11) | (kb[q] << 19); TB2[p1] = 0u; } }
                    LDS_WAIT();
                    if (ln == 63) { SPL[129] = (unsigned)(tot_spl < 128 ? tot_spl : 128); }
                }
                __syncthreads();
                __syncthreads();
                float* PO = (float*)(ws + WS_YF); float* PS = (float*)(ws + WS_SC);
#pragma unroll 1
                for (int rep = 0; rep < ((RPT_MASK & 8) ? 2 : 1); ++rep) {
                if (rep) xcd_barrier(bar);
                const unsigned nsub = SPL[128];
                for (;;) {
                    volatile LAS unsigned* slot = (volatile LAS unsigned*)(F.lds + MISC_OFF) + 16;
                    __syncthreads();
                    if (threadIdx.x == 0) *slot = atomicAdd(bnd + 32 + rep, 1u);
                    __syncthreads();
                    const unsigned u = *slot;
                    if (u >= nsub) break;
                    const unsigned e = TBL[u], ss_ = TB2[u];
                    if (e == 0xFFFFFFFFu) continue;
                    const int idx = (int)(e & 511u), part = (int)((e >> 9) & 3u), kta = (int)((e >> 11) & 255u), ktb = (int)((e >> 19) & 255u);
                    const int qb = 31 - (idx >> 4), h = 15 - (idx & 15);
                    const size_t pslot = (size_t)ss_ * 2 + (part == 2 ? 1 : 0);
                    dattn_unit(F, (const bf16*)(ws + WS_QKV), (bf16*)(ws + WS_OB), stash, subg, lam, 1.f - li, h, qb, kta, ktb, part, PO + pslot * 65536, PS + pslot * 2048);
                }
                xcd_barrier(bar);
                const unsigned nspl = SPL[129];
                for (;;) {
                    volatile LAS unsigned* slot = (volatile LAS unsigned*)(F.lds + MISC_OFF) + 16;
                    __syncthreads();
                    if (threadIdx.x == 0) *slot = atomicAdd(bnd + 36 + rep, 1u);
                    __syncthreads();
                    const unsigned s = *slot;
                    if (s >= nspl) break;
                    const int idx = (int)SPL[s], qb = 31 - (idx >> 4), h = 15 - (idx & 15);
                    da_combine(F, (bf16*)(ws + WS_OB), PO + (size_t)s * 131072, PS + (size_t)s * 4096, subg, lam, 1.f - li, h, qb);
                }
                }
            }
            SEAM(pb + 1);
        }
        if (EN_WO && IN(pb + 2)) {
            unsigned char* ws = ldws(F);
            pg8::Gemm g{(const pg8::bf16_t*)(ws + WS_OB), (const pg8::bf16_t*)(ws + WS_WO) + (size_t)L * D * D, T, D, D, 0};
            pg8::StaticOrder S; S.init(T, D, F.G, (int)blockIdx.x);
            pg8::EpiResLnStat E{(const pg8::bf16_t*)(ws + WS_XB), (float*)nullptr, (pg8::bf16_t*)(ws + WS_XF), ldin(F, 11) + L * D, (unsigned long long*)(ws + WS_STAT) + (size_t)L * T * 2, D, ALPHA, ((PROBE_MASK & (isB ? 2 : 1)) ? 0.f : 1.f)};
            pg8::gemm_phase<pg8::EpiResLnStat, pg8::StaticOrder, true, true>(F.lds + RING_OFF, g, S, E, F.wave);
            SEAM(pb + 2);
        }
        if (false && EN_LN && IN(pb + 3)) {
 unsigned char* ws = ldws(F); RPT(16, ln_phase(F, (const float*)(ws + WS_YF), ldin(F, 11) + L * D, ldin(F, 12) + L * D, (float*)(ws + WS_XF), (bf16*)(ws + WS_XB))); SEAM(pb + 3); }
        if (EN_SC && IN(pb + 4)) {
            unsigned char* ws = ldws(F);
            pg8::Gemm g{(const pg8::bf16_t*)(ws + WS_XF), (const pg8::bf16_t*)(ws + WS_WEFF) + (size_t)L * 2048 * D, T, 2048, D, 0};
            pg8::StaticOrder S; S.init(T, 2048, F.G, (int)blockIdx.x);
            pg8::EpiScLn E{(_Float16*)(ws + WS_SC), 2048, (const long long*)(ws + WS_STAT) + (size_t)L * T * 2, (const float*)(ws + WS_CSW) + L * 2048, (const float*)(ws + WS_CSW) + DEPTH * 2048 + L * 2048, 1.f / D, LN_EPS};
            RPT(2, pg8::gemm_phase<pg8::EpiScLn, pg8::StaticOrder, true, true>(F.lds + RING_OFF, g, S, E, F.wave));
            SEAM(pb + 4);
        }
        if (EN_PEER && IN(pb + 5)) {
            unsigned char* ws = ldws(F);
            const int gw = F.vcu * NWAVES + F.wave, NGW = F.G * NWAVES;
            LAS unsigned char* wl = F.lds + RING_OFF + F.wave * PEER_WAVE_LDS;
            const bool last = (L == DEPTH - 1);
            {
                __syncthreads();
                for (int i = threadIdx.x; i < 4 * 512; i += NWAVES * 64) { const int v = i >> 9, e = i & 511; const float* srcv = (v == 0 ? ldin(F, 11) : v == 1 ? ldin(F, 12) : v == 2 ? ldin(F, 13) : ldin(F, 14)) + L * D;
                    *(LAS f32x4*)(F.lds + RING_OFF + PEER_LNV_OFF + v * 8192 + (e & 7) * 1024 + (e >> 3) * 16) = *(const GAS f32x4*)(srcv + 4 * e); }
                __syncthreads();
            }
            float* xf_out = last ? (float*)ldp_raw(F, PT_OUT) : (float*)nullptr;
#pragma unroll 1
            for (int rep = ((RPT_MASK & 32) ? 0 : 1); rep < 2; ++rep) {
            if (rep == 1 && (RPT_MASK & 32)) xcd_barrier(bar);
            float* xfo = rep ? xf_out : (float*)(ws + WS_QKV); bf16* xbo = (rep && !last) ? (bf16*)(ws + WS_XB) : (bf16*)nullptr;
            for (int grp = gw; grp < T / 4; grp += NGW)
                peer_group(F, wl, 4 * grp, (const _Float16*)(ws + WS_SC), (const bf16*)(ws + WS_XF), (const long long*)(ws + WS_STAT) + (size_t)L * T * 2, ldin(F, 11) + L * D, ldin(F, 12) + L * D, ws + WS_UT + (size_t)L * NE * (U_FP4 ? 1024 : 1536), ws + WS_VT + (size_t)L * NE * (V_FP4 ? 1024 : 1536), (const float*)(ws + WS_US) + L * NE, (const float*)(ws + WS_VS) + L * NE,
                           ldin(F, 13) + L * D, ldin(F, 14) + L * D, xfo, xbo, (float)((PEER_HS >> (4 * L)) & 15) * 0.5f - 1.f, (((PROBE_MASK & 64) && (L == DIAG_LAYER)) || (PROBE_MASK & 128)) ? (unsigned*)(ws + WS_STASH) : (unsigned*)nullptr, ldin(F, 17) + (size_t)L * NE * D, rep ? 3 : PEER_DRY);
            }
            SEAM(pb + 5);
        }
    }
#if (STOP_AFTER >= 0)
    if (IN(N_PHASES)) {
        unsigned char* ws = ldws(F); const f32x4* src = (const f32x4*)(ws + (COPY_SRC == 0 ? WS_XF : (COPY_SRC == 1 ? WS_YF : WS_SC))); f32x4* dst = (f32x4*)ldp_raw(F, PT_OUT);
        for (size_t i = (size_t)blockIdx.x * 512 + threadIdx.x; i < (size_t)T * D / 4; i += (size_t)gridDim.x * 512) dst[i] = src[i]; }
#endif
#if (PROBE_MASK & 64)
    if (IN(N_PHASES)) { if (blockIdx.x == 0 && threadIdx.x == 0) { const unsigned* dg = (const unsigned*)(ldws(F) + WS_CTL) + 2048;
        auto bucket = [](unsigned c) { unsigned b = 0; while (c) { ++b; c >>= 1; } return b > 8u ? 8u : b; };
        const unsigned a = bucket(__hip_atomic_load(dg + DIAG_A, __ATOMIC_RELAXED, __HIP_MEMORY_SCOPE_AGENT)), b = bucket(__hip_atomic_load(dg + DIAG_B, __ATOMIC_RELAXED, __HIP_MEMORY_SCOPE_AGENT));
        ((float*)ldp_raw(F, PT_OUT))[0] = 100.f * (float)((a + 1) * 10 + b); } }
#endif
#undef IN
#undef SEAM
}

#ifndef MK_PER_PHASE
#define MK_PER_PHASE 0
#endif
extern "C" void kernel_launch(void* const* d_in, const int* in_sizes, int n_in, void* d_out, int out_size, void* d_ws, size_t ws_size, hipStream_t stream) {
    static int grid = 0;
    if (grid == 0) {
        if (n_in != 19 || in_sizes[0] != T * D || out_size != T * D || ws_size < WS_END) { fprintf(stderr, "kernel_launch: unexpected shapes (n_in %d, in0 %d, out %d, ws %zu < %zu); nothing launched\n", n_in, n_in > 0 ? in_sizes[0] : -1, out_size, ws_size, (size_t)WS_END); grid = -1; return; }
        int dev = 0, cus = 0, per_cu = 0;
        if (hipGetDevice(&dev) != hipSuccess || hipDeviceGetAttribute(&cus, hipDeviceAttributeMultiprocessorCount, dev) != hipSuccess) { fprintf(stderr, "kernel_launch: device query failed\n"); grid = -1; return; }
        if (hipFuncSetAttribute((const void*)hybrid_fwd, hipFuncAttributeMaxDynamicSharedMemorySize, LDS_BYTES) != hipSuccess) { fprintf(stderr, "kernel_launch: hipFuncSetAttribute failed\n"); grid = -1; return; }
        if (hipOccupancyMaxActiveBlocksPerMultiprocessor(&per_cu, (const void*)hybrid_fwd, NWAVES * 64, LDS_BYTES) != hipSuccess || per_cu < 1)
            fprintf(stderr, "kernel_launch: note: occupancy query reports %d workgroups per CU\n", per_cu);
        (void)hipGetLastError();
        grid = cus;
    }
    if (grid < 0) return;
    if (hipMemsetAsync((char*)d_ws + WS_CTL, 0, CTL_ZERO_BYTES, stream) != hipSuccess) { fprintf(stderr, "kernel_launch: memset failed\n"); return; }
    Args a{};
    for (int i = 0; i < 19; ++i) a.in[i] = (const float*)d_in[i];
    a.out = (float*)d_out; a.ws = (unsigned char*)d_ws; a.pad = 0;
#if MK_PER_PHASE
    for (int p = 0; p < N_PHASES + (((PROBE_MASK & 64) || STOP_AFTER >= 0) ? 1 : 0); ++p) { if (STOP_AFTER >= 0 && p > STOP_AFTER && p < N_PHASES) continue; a.ph_lo = p; a.ph_hi = p + 1; a.li = 0;
        hipLaunchKernelGGL(hybrid_fwd, dim3(grid), dim3(NWAVES * 64), LDS_BYTES, stream, a);
        if (hipPeekAtLastError() != hipSuccess) { fprintf(stderr, "kernel_launch: launch of phase %d failed\n", p); break; }
#if (PROBE_MASK & 64)
        if (p == 2 + 6 * DIAG_LAYER + 5) hipLaunchKernelGGL(peer_cmp_kernel, dim3(32), dim3(64), 0, stream, (const unsigned char*)d_ws);
        if (p == 2 + 6 * DIAG_LAYER + 4) hipLaunchKernelGGL(peer_ref_kernel, dim3(32), dim3(64), 0, stream, (const unsigned char*)d_ws, (const float*)d_in[17], (size_t)DIAG_LAYER * NE * D, (size_t)(WS_CTL + 4 * (2048 + 16384)), 256, 32);
#endif
    }
#else
    a.ph_lo = 0; a.ph_hi = N_PHASES; a.li = 0;
    hipLaunchKernelGGL(hybrid_fwd, dim3(grid), dim3(NWAVES * 64), LDS_BYTES, stream, a);
    if (hipPeekAtLastError() != hipSuccess) fprintf(stderr, "kernel_launch: launch failed\n");
#endif
}
```
